# Optimizing an MI355X kernel written in HIP

```python
import math
import jax, jax.numpy as jnp
from jax import lax
import numpy as np

D_MODEL = 1024
BATCH = 8
SEQ = 2048
DEPTH = 4
DEC_BATCH = 128
DEC_SEQ = 1
PAST_LEN = 8192
PAGE_SIZE = 128

N_EVEN = (DEPTH + 1) // 2
N_ODD = DEPTH // 2
EPS = 1e-6
NEG_INF = -1e30
D_FF = 2816

WINDOW = 128
BLOCK = 128
H_A = 8
KV_A = 2
G_A = H_A // KV_A
HD_A = 64
N_BUCKETS = 32
MAX_DIST = 128

H_B = 4
DK_B = 128
DV_B = 128
CONV_W = 4
GDN_CHUNK = 64

D_INNER = 2 * D_MODEL
P_C = 64
H_C = D_INNER // P_C
N_C = 128
G_C = 4
HPG = H_C // G_C
SSD_CHUNK = 128

A_Q = H_A * HD_A
A_K = KV_A * HD_A
A_V = KV_A * HD_A
B_Q = H_B * DK_B
B_K = H_B * DK_B
B_V = H_B * DV_B
B_Z = H_B * DV_B
GDN_CONV_CH = B_Q + B_K + B_V
EVEN_IN = A_Q + A_K + A_V + GDN_CONV_CH + B_Z + 2 * H_B
EVEN_MIX = A_Q + B_V
SSD_CONV_CH = D_INNER + 2 * G_C * N_C
ODD_IN = D_INNER + SSD_CONV_CH + H_C

kernel_name = "hybrid_swa_gdn_ssd_macaron_step"


def rmsnorm(x, g):
    xf = x.astype(jnp.float32)
    y = xf * lax.rsqrt(jnp.mean(xf * xf, axis=-1, keepdims=True) + EPS)
    return (y * g.astype(jnp.float32)).astype(x.dtype)


def l2norm(x):
    xf = x.astype(jnp.float32)
    return xf * lax.rsqrt(jnp.sum(xf * xf, axis=-1, keepdims=True) + EPS)


def swiglu(x, wg, wu, wd):
    return (jax.nn.silu(x @ wg) * (x @ wu)) @ wd


def pad_seq(t, lp):
    return jnp.pad(t, [(0, 0), (0, lp - t.shape[1])] + [(0, 0)] * (t.ndim - 2))


def causal_conv(x, hist, w):
    L = x.shape[1]
    xx = jnp.concatenate([hist.astype(x.dtype), x], axis=1)
    out = xx[:, 0:L] * w[0]
    for i in range(1, CONV_W):
        out = out + xx[:, i:i + L] * w[i]
    return out, xx[:, xx.shape[1] - (CONV_W - 1):]


def t5_bucket(dist):
    max_exact = N_BUCKETS // 2
    df = jnp.maximum(dist, max_exact).astype(jnp.float32)
    large = max_exact + (jnp.log(df / max_exact) / math.log(MAX_DIST / max_exact)
                         * (N_BUCKETS - max_exact)).astype(jnp.int32)
    return jnp.where(dist < max_exact, dist, jnp.minimum(large, N_BUCKETS - 1))


def band_bias(n_q, n_k, offset, rel_bias):
    d = offset + jnp.arange(n_q)[:, None] - jnp.arange(n_k)[None, :]
    valid = (d >= 0) & (d <= WINDOW)
    b = jnp.take(rel_bias.astype(jnp.float32), t5_bucket(jnp.clip(d, 0, WINDOW)), axis=0)
    b = jnp.where(valid[..., None], b, NEG_INF)
    return jnp.moveaxis(b, -1, 0).reshape(KV_A, G_A, n_q, n_k)


def sink_attention(q, k, v, bias, sinks):
    s = jnp.einsum('...qhgd,...khd->...hgqk', q, k).astype(jnp.float32) * (HD_A ** -0.5) + bias
    sk = sinks.astype(jnp.float32)[..., None, None]
    m = jnp.maximum(jnp.max(s, axis=-1, keepdims=True), sk)
    p = jnp.exp(s - m)
    denom = jnp.sum(p, axis=-1, keepdims=True) + jnp.exp(sk - m)
    return jnp.einsum('...hgqk,...khd->...qhgd', (p / denom).astype(v.dtype), v)


def gated_delta_chunked(q, k, v, g, beta, S0):
    Bn, L = q.shape[:2]
    C = min(GDN_CHUNK, L)
    lp = -(-L // C) * C
    nc = lp // C
    q, k, v, g, beta = [pad_seq(t.astype(jnp.float32), lp) for t in (q, k, v, g, beta)]

    def chunks(t):
        return jnp.moveaxis(t.reshape(Bn, nc, C, *t.shape[2:]), 2, 3)

    qc, kc, vc, bc = chunks(q), chunks(k), chunks(v), chunks(beta)
    gc = jnp.cumsum(chunks(g), axis=-1)
    tril = jnp.tril(jnp.ones((C, C), bool))
    strict = jnp.tril(jnp.ones((C, C), bool), -1)
    decay = jnp.exp(jnp.where(tril, gc[..., :, None] - gc[..., None, :], -jnp.inf))
    kb = kc * bc[..., None]
    M = jnp.where(strict, jnp.einsum('...id,...jd->...ij', kb, kc) * decay, 0.0)
    rhs = jnp.concatenate([vc * bc[..., None], kb * jnp.exp(gc)[..., None]], axis=-1)
    sol = lax.linalg.triangular_solve(M + jnp.eye(C, dtype=jnp.float32), rhs,
                                      left_side=True, lower=True, unit_diagonal=True)
    u, w = sol[..., :DV_B], sol[..., DV_B:]
    Aqk = jnp.einsum('...id,...jd->...ij', qc, kc) * decay
    qg = qc * jnp.exp(gc)[..., None]
    kd = kc * jnp.exp(gc[..., -1:] - gc)[..., None]
    gl = jnp.exp(gc[..., -1])

    def step(S, inp):
        u_i, w_i, qg_i, kd_i, A_i, gl_i = inp
        v_new = u_i - jnp.einsum('bhcd,bhde->bhce', w_i, S)
        o = jnp.einsum('bhcd,bhde->bhce', qg_i, S) + jnp.einsum('bhij,bhje->bhie', A_i, v_new)
        S = S * gl_i[..., None, None] + jnp.einsum('bhcd,bhce->bhde', kd_i, v_new)
        return S, o

    mv = lambda t: jnp.moveaxis(t, 1, 0)
    S_fin, o = lax.scan(step, S0.astype(jnp.float32), (mv(u), mv(w), mv(qg), mv(kd), mv(Aqk), mv(gl)))
    o = jnp.transpose(o, (1, 0, 3, 2, 4)).reshape(Bn, lp, H_B, DV_B)[:, :L]
    return o, S_fin


def ssd_chunked(x, dt, A, Bm, Cm, S0):
    Bn, L = x.shape[:2]
    C = min(SSD_CHUNK, L)
    lp = -(-L // C) * C
    nc = lp // C
    x, dt, Bm, Cm = [pad_seq(t.astype(jnp.float32), lp) for t in (x, dt, Bm, Cm)]
    a = (dt * A.astype(jnp.float32)).reshape(Bn, nc, C, G_C, HPG)
    xdt = (x * dt[..., None]).reshape(Bn, nc, C, G_C, HPG, P_C)
    Bc = Bm.reshape(Bn, nc, C, G_C, N_C)
    Cc = Cm.reshape(Bn, nc, C, G_C, N_C)
    acum = jnp.cumsum(a, axis=2)
    tril = jnp.tril(jnp.ones((C, C), bool))[:, :, None, None]
    diff = acum[:, :, :, None] - acum[:, :, None, :]
    Lmat = jnp.exp(jnp.where(tril, diff, -jnp.inf))
    scores = jnp.einsum('bclgn,bcsgn->bclsg', Cc, Bc)[..., None] * Lmat
    y = jnp.einsum('bclsgh,bcsghp->bclghp', scores, xdt)
    decay_to_end = jnp.exp(acum[:, :, -1:] - acum)
    chunk_states = jnp.einsum('bcsgn,bcsgh,bcsghp->bcghpn', Bc, decay_to_end, xdt)
    chunk_decay = jnp.exp(acum[:, :, -1])

    def step(S, inp):
        C_i, acum_i, cs_i, cd_i = inp
        y_off = jnp.einsum('blgn,bghpn,blgh->blghp', C_i, S, jnp.exp(acum_i))
        S = S * cd_i[..., None, None] + cs_i
        return S, y_off

    mv = lambda t: jnp.moveaxis(t, 1, 0)
    S0g = S0.astype(jnp.float32).reshape(Bn, G_C, HPG, P_C, N_C)
    S_fin, y_off = lax.scan(step, S0g, (mv(Cc), mv(acum), mv(chunk_states), mv(chunk_decay)))
    y = (y + jnp.moveaxis(y_off, 0, 1)).reshape(Bn, lp, H_C, P_C)[:, :L]
    return y, S_fin.reshape(Bn, H_C, P_C, N_C)


def even_mixer(h, w_in, w_out, sinks, rel_bias, conv_w, A_log, dt_bias, norm_g, win_k, win_v, conv_hist, S0):
    Bn, L, _ = h.shape
    sizes = [A_Q, A_K, A_V, GDN_CONV_CH, B_Z, H_B, H_B]
    idx = [int(i) for i in np.cumsum(sizes)[:-1]]
    q_a, k_a, v_a, qkv_b, z_b, b_b, a_b = jnp.split(h @ w_in, idx, axis=-1)
    q_a = q_a.reshape(Bn, L, KV_A, G_A, HD_A)
    k_a = k_a.reshape(Bn, L, KV_A, HD_A)
    v_a = v_a.reshape(Bn, L, KV_A, HD_A)
    sk = sinks.reshape(KV_A, G_A)
    if win_k is None:
        nb = L // BLOCK
        qb = q_a.reshape(Bn, nb, BLOCK, KV_A, G_A, HD_A)

        def band(t):
            tb = t.reshape(Bn, nb, BLOCK, KV_A, HD_A)
            prev = jnp.pad(tb, ((0, 0), (1, 0), (0, 0), (0, 0), (0, 0)))[:, :-1]
            return jnp.concatenate([prev, tb], axis=2)

        bias = band_bias(BLOCK, 2 * BLOCK, BLOCK, rel_bias)
        pad_keys = (jnp.arange(nb)[:, None] == 0) & (jnp.arange(2 * BLOCK)[None, :] < BLOCK)
        bias = jnp.where(pad_keys[:, None, None, None, :], NEG_INF, bias[None])
        o_a = sink_attention(qb, band(k_a), band(v_a), bias, sk)
        new_k, new_v = k_a[:, L - WINDOW:], v_a[:, L - WINDOW:]
    else:
        lc = win_k.shape[1]
        kk = jnp.concatenate([win_k.astype(k_a.dtype), k_a], axis=1)
        vv = jnp.concatenate([win_v.astype(v_a.dtype), v_a], axis=1)
        bias = band_bias(L, lc + L, lc, rel_bias)
        o_a = sink_attention(q_a, kk, vv, bias, sk)
        new_k, new_v = kk[:, L:], vv[:, L:]
    o_a = o_a.reshape(Bn, L, A_Q)
    conv, new_conv = causal_conv(qkv_b, conv_hist, conv_w)
    conv = jax.nn.silu(conv)
    q_b, k_b, v_b = jnp.split(conv, [B_Q, B_Q + B_K], axis=-1)
    q_b = l2norm(q_b.reshape(Bn, L, H_B, DK_B)) * (DK_B ** -0.5)
    k_b = l2norm(k_b.reshape(Bn, L, H_B, DK_B))
    v_b = v_b.reshape(Bn, L, H_B, DV_B)
    beta = jax.nn.sigmoid(b_b.astype(jnp.float32))
    g = -jnp.exp(A_log.astype(jnp.float32)) * jax.nn.softplus(a_b.astype(jnp.float32) + dt_bias.astype(jnp.float32))
    o_b, S_new = gated_delta_chunked(q_b, k_b, v_b, g, beta, S0)
    o_b = rmsnorm(o_b.astype(h.dtype), norm_g) * jax.nn.silu(z_b.reshape(Bn, L, H_B, DV_B))
    o = jnp.concatenate([o_a, o_b.reshape(Bn, L, B_V)], axis=-1) @ w_out
    return o, (new_k, new_v, new_conv, S_new.astype(S0.dtype))


def odd_mixer(h, w_in, w_out, conv_w, conv_b, dt_bias, A_log, D_skip, norm_g, conv_hist, S0):
    Bn, L, _ = h.shape
    z, xbc, dt = jnp.split(h @ w_in, [D_INNER, D_INNER + SSD_CONV_CH], axis=-1)
    xbc, new_conv = causal_conv(xbc, conv_hist, conv_w)
    xbc = jax.nn.silu(xbc + conv_b)
    xs, Bm, Cm = jnp.split(xbc, [D_INNER, D_INNER + G_C * N_C], axis=-1)
    xs = xs.reshape(Bn, L, H_C, P_C)
    Bm = Bm.reshape(Bn, L, G_C, N_C)
    Cm = Cm.reshape(Bn, L, G_C, N_C)
    dt = jax.nn.softplus(dt.astype(jnp.float32) + dt_bias.astype(jnp.float32))
    A = -jnp.exp(A_log.astype(jnp.float32))
    y, S_new = ssd_chunked(xs, dt, A, Bm, Cm, S0)
    y = y + D_skip.astype(jnp.float32)[:, None] * xs.astype(jnp.float32)
    y = y.reshape(Bn, L, D_INNER).astype(h.dtype) * jax.nn.silu(z)
    gs = D_INNER // G_C
    y = rmsnorm(y.reshape(Bn, L, G_C, gs), norm_g.reshape(G_C, gs)).reshape(Bn, L, D_INNER)
    return y @ w_out, (new_conv, S_new.astype(S0.dtype))


def trunk(x, states, W):
    (rel_bias, norm_ff1, norm_mix, norm_ff2, norm_final,
     ff1_gate, ff1_up, ff1_down, ff2_gate, ff2_up, ff2_down,
     even_w_in, even_w_out, swa_sinks, gdn_conv_w, gdn_A_log, gdn_dt_bias, gdn_norm,
     ssd_w_in, ssd_w_out, ssd_conv_w, ssd_conv_b, ssd_dt_bias, ssd_A_log, ssd_D, ssd_norm) = W
    Bn = x.shape[0]
    ks, vs, gconv, gssm, sconv, sssm = [], [], [], [], [], []
    for l in range(DEPTH):
        x = x + 0.5 * swiglu(rmsnorm(x, norm_ff1[l]), ff1_gate[l], ff1_up[l], ff1_down[l])
        h = rmsnorm(x, norm_mix[l])
        if l % 2 == 0:
            e = l // 2
            if states is None:
                wk = wv = None
                ch = jnp.zeros((Bn, CONV_W - 1, GDN_CONV_CH), x.dtype)
                S0 = jnp.zeros((Bn, H_B, DK_B, DV_B), x.dtype)
            else:
                wk, wv, ch, S0 = states[0][e], states[1][e], states[2][e], states[3][e]
            o, (nk, nv, nc_, ns) = even_mixer(h, even_w_in[e], even_w_out[e], swa_sinks[e], rel_bias,
                                              gdn_conv_w[e], gdn_A_log[e], gdn_dt_bias[e], gdn_norm[e],
                                              wk, wv, ch, S0)
            ks.append(nk); vs.append(nv); gconv.append(nc_); gssm.append(ns)
        else:
            e = l // 2
            if states is None:
                ch = jnp.zeros((Bn, CONV_W - 1, SSD_CONV_CH), x.dtype)
                S0 = jnp.zeros((Bn, H_C, P_C, N_C), x.dtype)
            else:
                ch, S0 = states[4][e], states[5][e]
            o, (nc_, ns) = odd_mixer(h, ssd_w_in[e], ssd_w_out[e], ssd_conv_w[e], ssd_conv_b[e],
                                     ssd_dt_bias[e], ssd_A_log[e], ssd_D[e], ssd_norm[e], ch, S0)
            sconv.append(nc_); sssm.append(ns)
        x = x + o
        x = x + 0.5 * swiglu(rmsnorm(x, norm_ff2[l]), ff2_gate[l], ff2_up[l], ff2_down[l])
    y = rmsnorm(x, norm_final)
    return (y, jnp.stack(ks), jnp.stack(vs), jnp.stack(gconv), jnp.stack(gssm),
            jnp.stack(sconv), jnp.stack(sssm))


def setup_inputs(seed: int = 0) -> dict:
    key = jax.random.key(seed)
    ks = iter(jax.random.split(key, 64))

    def nrm(shape, s=1.0):
        return s * jax.random.normal(next(ks), shape, jnp.float32)

    def gain(shape):
        return 1.0 + nrm(shape, 0.05)

    def dt_bias_init(shape):
        u = jax.random.uniform(next(ks), shape, jnp.float32)
        dt = jnp.exp(u * (math.log(0.1) - math.log(0.001)) + math.log(0.001))
        return dt + jnp.log(-jnp.expm1(-dt))

    def a_log_init(shape):
        return jnp.log(jax.random.uniform(next(ks), shape, jnp.float32, 1.0, 16.0))

    win = min(WINDOW, PAST_LEN)
    d = D_MODEL
    return {
        "x_prompt": nrm((BATCH, SEQ, d)),
        "x_sample": nrm((DEC_BATCH, DEC_SEQ, d)),
        "cache_swa_k": nrm((N_EVEN, DEC_BATCH, win, KV_A, HD_A)),
        "cache_swa_v": nrm((N_EVEN, DEC_BATCH, win, KV_A, HD_A)),
        "state_gdn_conv": nrm((N_EVEN, DEC_BATCH, CONV_W - 1, GDN_CONV_CH)),
        "state_gdn_ssm": nrm((N_EVEN, DEC_BATCH, H_B, DK_B, DV_B), 0.1),
        "state_ssd_conv": nrm((N_ODD, DEC_BATCH, CONV_W - 1, SSD_CONV_CH)),
        "state_ssd_ssm": nrm((N_ODD, DEC_BATCH, H_C, P_C, N_C), 0.3),
        "rel_bias": nrm((N_BUCKETS, H_A), 0.5),
        "norm_ff1": gain((DEPTH, d)),
        "norm_mix": gain((DEPTH, d)),
        "norm_ff2": gain((DEPTH, d)),
        "norm_final": gain((d,)),
        "ff1_gate": nrm((DEPTH, d, D_FF), d ** -0.5),
        "ff1_up": nrm((DEPTH, d, D_FF), d ** -0.5),
        "ff1_down": nrm((DEPTH, D_FF, d), D_FF ** -0.5),
        "ff2_gate": nrm((DEPTH, d, D_FF), d ** -0.5),
        "ff2_up": nrm((DEPTH, d, D_FF), d ** -0.5),
        "ff2_down": nrm((DEPTH, D_FF, d), D_FF ** -0.5),
        "even_w_in": nrm((N_EVEN, d, EVEN_IN), d ** -0.5),
        "even_w_out": nrm((N_EVEN, EVEN_MIX, d), EVEN_MIX ** -0.5),
        "swa_sinks": nrm((N_EVEN, H_A), 0.5),
        "gdn_conv_w": nrm((N_EVEN, CONV_W, GDN_CONV_CH), CONV_W ** -0.5),
        "gdn_A_log": a_log_init((N_EVEN, H_B)),
        "gdn_dt_bias": dt_bias_init((N_EVEN, H_B)),
        "gdn_norm": gain((N_EVEN, DV_B)),
        "ssd_w_in": nrm((N_ODD, d, ODD_IN), d ** -0.5),
        "ssd_w_out": nrm((N_ODD, D_INNER, d), D_INNER ** -0.5),
        "ssd_conv_w": nrm((N_ODD, CONV_W, SSD_CONV_CH), CONV_W ** -0.5),
        "ssd_conv_b": nrm((N_ODD, SSD_CONV_CH), 0.01),
        "ssd_dt_bias": dt_bias_init((N_ODD, H_C)),
        "ssd_A_log": a_log_init((N_ODD, H_C)),
        "ssd_D": 1.0 + nrm((N_ODD, H_C), 0.1),
        "ssd_norm": gain((N_ODD, D_INNER)),
    }


def reference(x_prompt, x_sample, cache_swa_k, cache_swa_v, state_gdn_conv, state_gdn_ssm,
              state_ssd_conv, state_ssd_ssm, rel_bias, norm_ff1, norm_mix, norm_ff2, norm_final,
              ff1_gate, ff1_up, ff1_down, ff2_gate, ff2_up, ff2_down,
              even_w_in, even_w_out, swa_sinks, gdn_conv_w, gdn_A_log, gdn_dt_bias, gdn_norm,
              ssd_w_in, ssd_w_out, ssd_conv_w, ssd_conv_b, ssd_dt_bias, ssd_A_log, ssd_D, ssd_norm):
    W = (rel_bias, norm_ff1, norm_mix, norm_ff2, norm_final,
         ff1_gate, ff1_up, ff1_down, ff2_gate, ff2_up, ff2_down,
         even_w_in, even_w_out, swa_sinks, gdn_conv_w, gdn_A_log, gdn_dt_bias, gdn_norm,
         ssd_w_in, ssd_w_out, ssd_conv_w, ssd_conv_b, ssd_dt_bias, ssd_A_log, ssd_D, ssd_norm)
    y_prompt, p_k, p_v, p_gconv, p_gssm, p_sconv, p_sssm = trunk(x_prompt, None, W)
    states = (cache_swa_k, cache_swa_v, state_gdn_conv, state_gdn_ssm, state_ssd_conv, state_ssd_ssm)
    y_sample, s_k, s_v, s_gconv, s_gssm, s_sconv, s_sssm = trunk(x_sample, states, W)
    return (y_prompt, y_sample, p_k, p_v, p_gconv, p_gssm, p_sconv, p_sssm,
            s_k, s_v, s_gconv, s_gssm, s_sconv, s_sssm)
```

```cpp
#include <hip/hip_runtime.h>
#include <hip/hip_cooperative_groups.h>
#include <cstdio>
namespace cg = cooperative_groups;

typedef unsigned short bf16_t;
typedef short bf16x8 __attribute__((ext_vector_type(8)));
typedef float f32x4 __attribute__((ext_vector_type(4)));
typedef float f32x2 __attribute__((ext_vector_type(2)));
typedef unsigned u32x4 __attribute__((ext_vector_type(4)));
typedef unsigned u32x2 __attribute__((ext_vector_type(2)));
typedef unsigned long long u64;
#define SSQ_FIX 1048576.f
#define SSQ_INV (1.0f / (1048576.f * 1024.f))
#define LAS __attribute__((address_space(3)))

constexpr int D = 1024, TP = 16384, NSMP = 128, T = TP + NSMP, MP = 16640, DFF = 2816;
constexpr int EINP = 3072, OINP = 5376;
constexpr float EPS = 1e-6f;
constexpr int LDS_BYTES = 147456;

constexpr size_t O_YP = 0, O_YS = O_YP + 16777216ull, O_PK = O_YS + 131072ull, O_PV = O_PK + 262144ull, O_PGC = O_PV + 262144ull,
                 O_PGS = O_PGC + 73728ull, O_PSC = O_PGS + 1048576ull, O_PSS = O_PSC + 147456ull, O_SK = O_PSS + 4194304ull,
                 O_SV = O_SK + 4194304ull, O_SGC = O_SV + 4194304ull, O_SGS = O_SGC + 1179648ull, O_SSC = O_SGS + 16777216ull,
                 O_SSS = O_SSC + 2359296ull, O_END = O_SSS + 67108864ull;

constexpr size_t WS_CTL = 0, WS_SSQ = 4096;
constexpr size_t WS_WGU = (WS_SSQ + 13ull * MP * 8 + 255) & ~(size_t)255, SZ_WGU = 5632ull * 1024 * 2;
constexpr size_t WS_WD = WS_WGU + 8 * SZ_WGU, SZ_WD = 1024ull * 2816 * 2;
constexpr size_t WS_WEIN = WS_WD + 8 * SZ_WD, SZ_WEIN = 3072ull * 1024 * 2;
constexpr size_t WS_WEOUT = WS_WEIN + 2 * SZ_WEIN, SZ_WEOUT = 1024ull * 1024 * 2;
constexpr size_t WS_WOIN = WS_WEOUT + 2 * SZ_WEOUT, SZ_WOIN = 5376ull * 1024 * 2;
constexpr size_t WS_WOOUT = WS_WOIN + 2 * SZ_WOIN, SZ_WOOUT = 1024ull * 2048 * 2;
constexpr size_t WS_X = WS_WOOUT + 2 * SZ_WOOUT;
constexpr size_t WS_XG = WS_X + (size_t)MP * 1024 * 4;
constexpr size_t WS_MIX = WS_XG + (size_t)MP * 1024 * 2;
constexpr size_t WS_P = WS_MIX + (size_t)MP * 2048 * 2;
constexpr size_t WS_U = WS_P + (size_t)MP * 5376 * 4;
constexpr size_t U_XBC = 0;
constexpr size_t U_XBF = 0, U_YBF = (size_t)104 << 20;
constexpr size_t U_DT = (size_t)T * 3072 * 4;
constexpr size_t U_DA = U_DT + (size_t)T * 32 * 4;
constexpr size_t U_GQ = 0, U_GK = (size_t)T * 512 * 4, U_GV = 2 * U_GK, U_GO = 3 * U_GK, U_GA = 4 * U_GK, U_GB = U_GA + (size_t)T * 16, U_GKQ = U_GB + (size_t)T * 16;
constexpr size_t WS_GATE = WS_U + U_DA + (size_t)T * 32 * 4 + 4096;
constexpr size_t WS_BAR = WS_GATE + (size_t)MP * 32 * 4 + 4096;
constexpr size_t WS_END = WS_BAR + 16384;

struct Params { const float* in[34]; float* out; unsigned char* ws; };
__device__ __forceinline__ int ltid() { int t = threadIdx.x; asm volatile("" : "+v"(t)); return t; }
typedef const __attribute__((address_space(4))) Params* PP;
__device__ __forceinline__ PP get_params() { PP q = (PP)__builtin_amdgcn_kernarg_segment_ptr(); asm volatile("" : "+s"(q)); return q; }

__device__ __forceinline__ unsigned cvt_pk_bf16(float lo, float hi) { unsigned r; asm volatile("v_cvt_pk_bf16_f32 %0, %1, %2" : "=v"(r) : "v"(lo), "v"(hi)); return r; }
__device__ __forceinline__ float wave_max(float v) {
#pragma unroll
    for (int o = 1; o < 64; o <<= 1) v = fmaxf(v, __shfl_xor(v, o));
    return v;
}
__device__ __forceinline__ float dppf(float v, const int ctrl_unused) { return v; }
#define DPP_ADD(v, ctrl) v += __builtin_bit_cast(float, __builtin_amdgcn_update_dpp(0, __builtin_bit_cast(int, v), ctrl, 0xF, 0xF, true))
__device__ __forceinline__ float row16_sum(float v) {
    DPP_ADD(v, 0xB1); DPP_ADD(v, 0x4E); DPP_ADD(v, 0x141); DPP_ADD(v, 0x140);
    return v;
}
__device__ __forceinline__ float wave_sum(float v) {
    v = row16_sum(v);
    v += __shfl_xor(v, 16); v += __shfl_xor(v, 32);
    return v;
}
__device__ __forceinline__ float silu_f(float x) { return x / (1.f + __expf(-x)); }
__device__ __forceinline__ float softplus_f(float x) { return fmaxf(x, 0.f) + log1pf(__expf(-fabsf(x))); }
__device__ __forceinline__ int t5_bucket(int d) {
    if (d < 16) return d;
    const int large = 16 + (int)(logf((float)d * 0.0625f) / 2.0794415416798357f * 16.f);
    return large < 31 ? large : 31;
}
__device__ __forceinline__ bf16_t bf16_of(float v) { return (bf16_t)(cvt_pk_bf16(v, 0.f) & 0xffffu); }
__device__ __forceinline__ float bf_lo(unsigned w) { return __uint_as_float(w << 16); }
__device__ __forceinline__ float bf_hi(unsigned w) { return __uint_as_float(w & 0xffff0000u); }
__device__ __forceinline__ float bf_1(bf16_t b) { return __uint_as_float((unsigned)b << 16); }
__device__ __forceinline__ f32x4 bf4(u32x2 w) { return (f32x4){bf_lo(w.x), bf_hi(w.x), bf_lo(w.y), bf_hi(w.y)}; }
__device__ __forceinline__ float dot4(f32x4 a, f32x4 b) { return (a.x * b.x + a.y * b.y) + (a.z * b.z + a.w * b.w); }

namespace pg8 {
constexpr int BM = 256, BK = 64, HALF = 128, HTB = HALF * BK * 2, STAGE_BYTES = 8 * HTB, NXCD = 8, WGM = 8;
__device__ __forceinline__ int lds_byte(int r, int c) { const int st = (r >> 4) * 2 + (c >> 5), rr = r & 15, cc = c & 31, ob = rr * 64 + cc * 2; return st * 1024 + (ob ^ (((ob >> 9) & 1) << 5)); }
__device__ __forceinline__ void stage_rc(int b, int& R, int& C) { const int st = b / 1024, sb = b % 1024, swz = sb ^ (((sb >> 9) & 1) << 5); R = (st >> 1) * 16 + swz / 64; C = (st & 1) * 32 + (swz % 64) / 2; }
__device__ __forceinline__ int perm32(int rho) { const int n = rho >> 4, i = rho & 15; return 8 * (i >> 2) + 4 * n + (i & 3); }
struct Unit { int pm, pn; };
struct Gemm { const bf16_t* A; const bf16_t* Bt; int M, N, K; };
struct StaticOrder {
    int nM, nN, nwg, G, c;
    __device__ void init(int M, int N, int G_, int c_) { nM = M / BM; nN = N / BM; nwg = nM * nN; G = G_; c = c_; }
    __device__ bool next(int i, Unit& u) const {
        const long L = (long)i * G + c; if (L >= nwg) return false;
        int wgid = (int)L; { const int q = nwg / NXCD, r = nwg % NXCD, xcd = wgid % NXCD, off = wgid / NXCD; wgid = (xcd < r ? xcd * (q + 1) : r * (q + 1) + (xcd - r) * q) + off; }
        const int nig = WGM * nN, gid = wgid / nig, fm = gid * WGM, gsz = (nM - fm) < WGM ? (nM - fm) : WGM;
        u.pm = fm + ((wgid % nig) % gsz); u.pn = (wgid % nig) / gsz; return true;
    }
};

struct EpiSwiGLU {
    static constexpr bool PERM = true;
    bf16_t* H; const u64* ssq;
    __device__ __forceinline__ void operator()(const f32x4 (&acc)[2][2][4][2], const Unit& u, int wr, int wc, int fr, int fq) const {
        const int row0 = u.pm * BM + wr * 64 + fr, hid0 = u.pn * 128 + wc * 32 + 8 * fq;
        u64 sq[2][4];
#pragma unroll
        for (int ai = 0; ai < 2; ++ai)
#pragma unroll
            for (int m = 0; m < 4; ++m) sq[ai][m] = ssq[row0 + ai * HALF + m * 16];
#pragma unroll
        for (int ai = 0; ai < 2; ++ai)
#pragma unroll
            for (int m = 0; m < 4; ++m) {
                const int r = row0 + ai * HALF + m * 16;
                const float rs = rsqrtf((float)sq[ai][m] * SSQ_INV + EPS);
                float o[8];
#pragma unroll
                for (int n = 0; n < 2; ++n)
#pragma unroll
                    for (int j = 0; j < 4; ++j) { const float g = acc[ai][0][m][n][j] * rs, uu = acc[ai][1][m][n][j] * rs; o[n * 4 + j] = silu_f(g) * uu; }
                u32x4 w; w.x = cvt_pk_bf16(o[0], o[1]); w.y = cvt_pk_bf16(o[2], o[3]); w.z = cvt_pk_bf16(o[4], o[5]); w.w = cvt_pk_bf16(o[6], o[7]);
                *(u32x4*)(H + (size_t)r * DFF + hid0) = w;
            }
    }
};
struct EpiRowScale {
    static constexpr bool PERM = true;
    bf16_t* C; int ldc; const u64* ssq; float* gate; int gate_pn;
    __device__ __forceinline__ void operator()(const f32x4 (&acc)[2][2][4][2], const Unit& u, int wr, int wc, int fr, int fq) const {
        const int row0 = u.pm * BM + wr * 64 + fr, col0 = u.pn * BM + wc * 32 + 8 * fq;
        const bool dog = (u.pn == gate_pn) && (wc == 0);
        u64 sq[2][4];
#pragma unroll
        for (int ai = 0; ai < 2; ++ai)
#pragma unroll
            for (int m = 0; m < 4; ++m) sq[ai][m] = ssq[row0 + ai * HALF + m * 16];
#pragma unroll
        for (int ai = 0; ai < 2; ++ai)
#pragma unroll
            for (int m = 0; m < 4; ++m) {
                const int r = row0 + ai * HALF + m * 16;
                const float rs = rsqrtf((float)sq[ai][m] * SSQ_INV + EPS);
                bf16_t* rowp = C + (size_t)r * ldc + col0;
#pragma unroll
                for (int bj = 0; bj < 2; ++bj) { const f32x4 v0 = acc[ai][bj][m][0] * rs, v1 = acc[ai][bj][m][1] * rs;
                    u32x4 w; w.x = cvt_pk_bf16(v0.x, v0.y); w.y = cvt_pk_bf16(v0.z, v0.w); w.z = cvt_pk_bf16(v1.x, v1.y); w.w = cvt_pk_bf16(v1.z, v1.w);
                    *(u32x4*)(rowp + bj * HALF) = w; }
                if (dog) { *(f32x4*)(gate + (size_t)r * 32 + 8 * fq) = acc[ai][0][m][0] * rs; *(f32x4*)(gate + (size_t)r * 32 + 8 * fq + 4) = acc[ai][0][m][1] * rs; }
            }
    }
};
struct EpiResidual {
    static constexpr bool PERM = false;
    float* X; bf16_t* XG; const float* gnext; u64* ssqn; float scale;
    __device__ __forceinline__ void operator()(const f32x4 (&acc)[2][2][4][2], const Unit& u, int wr, int wc, int fr, int fq) const {
        const int row0 = u.pm * BM + wr * 64 + fr, col0 = u.pn * BM + wc * 32 + 4 * fq;
        f32x4 gv[2][2];
#pragma unroll
        for (int bj = 0; bj < 2; ++bj)
#pragma unroll
            for (int n = 0; n < 2; ++n) gv[bj][n] = *(const f32x4*)(gnext + col0 + bj * HALF + n * 16);
#pragma unroll
        for (int ai2 = 0; ai2 < 4; ++ai2) {
          const int ai = ai2 >> 1, mb = (ai2 & 1) * 2;
          f32x4 xin[4][2][2];
#pragma unroll
          for (int m = 0; m < 2; ++m)
#pragma unroll
              for (int bj = 0; bj < 2; ++bj)
#pragma unroll
                  for (int n = 0; n < 2; ++n) xin[mb + m][bj][n] = *(const f32x4*)(X + (size_t)(row0 + ai * HALF + (mb + m) * 16) * D + col0 + bj * HALF + n * 16);
#pragma unroll
            for (int m = mb; m < mb + 2; ++m) {
                const int r = row0 + ai * HALF + m * 16;
                float* xp = X + (size_t)r * D + col0; bf16_t* gp = XG + (size_t)r * D + col0;
                float ss = 0.f;
#pragma unroll
                for (int bj = 0; bj < 2; ++bj)
#pragma unroll
                    for (int n = 0; n < 2; ++n) {
                        f32x4 xv = xin[m][bj][n];
                        xv = xv + acc[ai][bj][m][n] * scale;
                        *(f32x4*)(xp + bj * HALF + n * 16) = xv;
                        ss += dot4(xv, xv);
                        const f32x4 t = xv * gv[bj][n];
                        u32x2 w; w.x = cvt_pk_bf16(t.x, t.y); w.y = cvt_pk_bf16(t.z, t.w);
                        *(u32x2*)(gp + bj * HALF + n * 16) = w;
                    }
                ss += __shfl_xor(ss, 16); ss += __shfl_xor(ss, 32);
                if (fq == 0) atomicAdd(ssqn + r, (u64)(ss * SSQ_FIX + 0.5f));
            }
        }
    }
};

template <class Epi>
__device__ __forceinline__ void gemm_phase(LAS unsigned char* lds, const Gemm g, const StaticOrder& S, const Epi& E) {
    const int tid = ltid(), wid = __builtin_amdgcn_readfirstlane(tid >> 6), lane = tid & 63, wr = wid >> 2, wc = wid & 3, fr = lane & 15, fq = lane >> 4;
    const int K = g.K, nt = K / BK;
    unsigned voffA[2], voffB[2];
#pragma unroll
    for (int i = 0; i < 2; ++i) { int R, C; stage_rc(tid * 16 + i * 8192, R, C); const int Rb = Epi::PERM ? ((R & ~31) + perm32(R & 31)) : R;
        voffA[i] = (unsigned)(R * K + C) * 2u; voffB[i] = (unsigned)(Rb * K + C) * 2u; }
    const size_t kstep = (size_t)(BK * 2);
    const size_t hstep = (size_t)HALF * K * 2;
    const size_t tstep = 2 * hstep;
    const unsigned ldsw = (unsigned)wid * 1024u;
    const int aoff = lds_byte(wr * 64 + fr, fq * 8), boff = lds_byte(wc * 32 + fr, fq * 8);
#define PG8_SA(b, h) (((b) * 2 + (h)) * HTB)
#define PG8_SB(b, h) ((4 + (b) * 2 + (h)) * HTB)
#define PG8_STAGE(bufoff, gbase, voff) do { _Pragma("unroll") for (int _i = 0; _i < 2; ++_i) \
        __builtin_amdgcn_global_load_lds((const unsigned*)((const char*)(gbase) + (voff)[_i]), (LAS unsigned*)(lds + (bufoff) + ldsw + _i * 8192), 16, 0, 0); } while (0)
#define PG8_LDA(dst, b, h) do { _Pragma("unroll") for (int m = 0; m < 4; ++m) _Pragma("unroll") for (int k = 0; k < 2; ++k) dst[m][k] = *(const LAS bf16x8*)(lds + PG8_SA(b, h) + aoff + m * 2048 + k * 1024); } while (0)
#define PG8_LDB(dst, b, h) do { _Pragma("unroll") for (int n = 0; n < 2; ++n) _Pragma("unroll") for (int k = 0; k < 2; ++k) dst[n][k] = *(const LAS bf16x8*)(lds + PG8_SB(b, h) + boff + n * 2048 + k * 1024); } while (0)
#define PG8_MMA(ai, bj, At, Bt) do { __builtin_amdgcn_s_setprio(1); _Pragma("unroll") for (int m = 0; m < 4; ++m) _Pragma("unroll") for (int n = 0; n < 2; ++n) _Pragma("unroll") for (int k = 0; k < 2; ++k) \
        acc[ai][bj][m][n] = __builtin_amdgcn_mfma_f32_16x16x32_bf16(Bt[n][k], At[m][k], acc[ai][bj][m][n], 0, 0, 0); __builtin_amdgcn_s_setprio(0); } while (0)
#define PG8_WAIT_V(n) asm volatile("s_waitcnt vmcnt(" #n ")" ::: "memory")
#define PG8_WAIT_L(n) asm volatile("s_waitcnt lgkmcnt(" #n ")" ::: "memory")
#define PG8_BAR __builtin_amdgcn_s_barrier()
#define PG8_SCHED __builtin_amdgcn_sched_barrier(0)
    Unit cur, nxt; int ui = 0;
    if (!S.next(0, cur)) return;
    f32x4 acc[2][2][4][2];
#pragma unroll
    for (int a = 0; a < 2; ++a)
#pragma unroll
        for (int b = 0; b < 2; ++b)
#pragma unroll
            for (int m = 0; m < 4; ++m)
#pragma unroll
                for (int n = 0; n < 2; ++n) acc[a][b][m][n] = (f32x4){0.f, 0.f, 0.f, 0.f};
    bf16x8 At[4][2], B0[2][2], B1[2][2];
    const char* cA = (const char*)g.A + (size_t)cur.pm * tstep; const char* cB = (const char*)g.Bt + (size_t)cur.pn * tstep;
    PG8_STAGE(PG8_SB(0, 0), cB, voffB); PG8_STAGE(PG8_SA(0, 0), cA, voffA); PG8_STAGE(PG8_SB(0, 1), cB + hstep, voffB); PG8_STAGE(PG8_SA(0, 1), cA + hstep, voffA);
    if (wr == 1) PG8_BAR;
    PG8_WAIT_V(4); PG8_BAR;
    PG8_STAGE(PG8_SB(1, 0), cB + kstep, voffB); PG8_STAGE(PG8_SA(1, 0), cA + kstep, voffA); PG8_STAGE(PG8_SB(1, 1), cB + hstep + kstep, voffB);
    PG8_WAIT_V(6); PG8_BAR;
    for (;;) {
        const bool has_next = S.next(ui + 1, nxt);
        const char* nA = has_next ? (const char*)g.A + (size_t)nxt.pm * tstep : cA; const char* nB = has_next ? (const char*)g.Bt + (size_t)nxt.pn * tstep : cB;
        for (int t = 0; t < nt; t += 2) {
            const bool last = (t == nt - 2);
            const char* a1 = cA + (size_t)(t + 1) * kstep;
            const char* a2 = last ? nA : cA + (size_t)(t + 2) * kstep; const char* b2 = last ? nB : cB + (size_t)(t + 2) * kstep;
            const char* a3 = a2 + kstep; const char* b3 = b2 + kstep;
            PG8_LDB(B0, 0, 0); PG8_SCHED; PG8_LDA(At, 0, 0); PG8_STAGE(PG8_SA(1, 1), a1 + hstep, voffA);
            PG8_WAIT_L(8); PG8_BAR; PG8_WAIT_L(0); PG8_MMA(0, 0, At, B0); PG8_BAR; PG8_SCHED;
            PG8_LDB(B1, 0, 1); PG8_STAGE(PG8_SB(0, 0), b2, voffB);
            PG8_BAR; PG8_WAIT_L(0); PG8_MMA(0, 1, At, B1); PG8_BAR;
            PG8_LDA(At, 0, 1); PG8_STAGE(PG8_SA(0, 0), a2, voffA);
            PG8_BAR; PG8_WAIT_L(0); PG8_MMA(1, 0, At, B0); PG8_BAR; PG8_SCHED;
            PG8_STAGE(PG8_SB(0, 1), b2 + hstep, voffB);
            PG8_WAIT_V(6); PG8_BAR; PG8_MMA(1, 1, At, B1); PG8_BAR;
            PG8_LDB(B0, 1, 0); PG8_SCHED; PG8_LDA(At, 1, 0); PG8_STAGE(PG8_SA(0, 1), a2 + hstep, voffA);
            PG8_WAIT_L(8); PG8_BAR; PG8_WAIT_L(0); PG8_MMA(0, 0, At, B0); PG8_BAR; PG8_SCHED;
            PG8_LDB(B1, 1, 1); PG8_STAGE(PG8_SB(1, 0), b3, voffB);
            PG8_BAR; PG8_WAIT_L(0); PG8_MMA(0, 1, At, B1); PG8_BAR;
            PG8_LDA(At, 1, 1); PG8_STAGE(PG8_SA(1, 0), a3, voffA);
            PG8_BAR; PG8_WAIT_L(0); PG8_MMA(1, 0, At, B0); PG8_BAR; PG8_SCHED;
            PG8_STAGE(PG8_SB(1, 1), b3 + hstep, voffB);
            PG8_WAIT_V(6); PG8_BAR; PG8_MMA(1, 1, At, B1); PG8_BAR;
        }
        E(acc, cur, wr, wc, fr, fq);
        if (!has_next) break;
#pragma unroll
        for (int a = 0; a < 2; ++a)
#pragma unroll
            for (int b = 0; b < 2; ++b)
#pragma unroll
                for (int m = 0; m < 4; ++m)
#pragma unroll
                    for (int n = 0; n < 2; ++n) acc[a][b][m][n] = (f32x4){0.f, 0.f, 0.f, 0.f};
        cur = nxt; cA = nA; cB = nB; ++ui;
    }
    PG8_WAIT_V(0);
    if (wr == 0) PG8_BAR;
    PG8_BAR;
#undef PG8_SA
#undef PG8_SB
#undef PG8_STAGE
#undef PG8_LDA
#undef PG8_LDB
#undef PG8_MMA
#undef PG8_WAIT_V
#undef PG8_WAIT_L
#undef PG8_BAR
#undef PG8_SCHED
}
}

__device__ __forceinline__ void skinny_residual(const bf16_t* __restrict__ A, const bf16_t* __restrict__ Bt, int K, float* X, bf16_t* XG, const float* gnext, u64* ssqn, float scale, unsigned char* lds) {
    const int tid = ltid(), wave = tid >> 6, lane = tid & 63, kq = wave & 3;
    const int tile = blockIdx.x * 2 + (wave >> 2);
    const int tb = tile & 7, cb = tile >> 3, row0 = TP + tb * 16, n0 = cb * 16, fr = lane & 15, fq = lane >> 4;
    const int Kq = K >> 2;
    f32x4 acc0 = (f32x4){0.f, 0.f, 0.f, 0.f}, acc1 = acc0;
    if (tile < 512) {
        const bf16_t* ap = A + (size_t)(row0 + fr) * K + kq * Kq + fq * 8; const bf16_t* bp = Bt + (size_t)(n0 + fr) * K + kq * Kq + fq * 8;
#pragma unroll 4
        for (int k0 = 0; k0 < Kq; k0 += 64) {
            const bf16x8 w0 = *(const bf16x8*)(bp + k0), x0 = *(const bf16x8*)(ap + k0), w1 = *(const bf16x8*)(bp + k0 + 32), x1 = *(const bf16x8*)(ap + k0 + 32);
            acc0 = __builtin_amdgcn_mfma_f32_16x16x32_bf16(w0, x0, acc0, 0, 0, 0);
            acc1 = __builtin_amdgcn_mfma_f32_16x16x32_bf16(w1, x1, acc1, 0, 0, 0);
        }
    }
    f32x4* red = (f32x4*)lds;
    red[wave * 64 + lane] = acc0 + acc1;
    __syncthreads();
    if (kq == 0 && tile < 512) {
        const f32x4 acc = (red[wave * 64 + lane] + red[(wave + 1) * 64 + lane]) + (red[(wave + 2) * 64 + lane] + red[(wave + 3) * 64 + lane]);
        const int r = row0 + fr, c = n0 + 4 * fq;
        f32x4 xv = *(const f32x4*)(X + (size_t)r * D + c);
        xv = xv + acc * scale;
        *(f32x4*)(X + (size_t)r * D + c) = xv;
        float ss = dot4(xv, xv);
        const f32x4 t = xv * *(const f32x4*)(gnext + c);
        u32x2 w; w.x = cvt_pk_bf16(t.x, t.y); w.y = cvt_pk_bf16(t.z, t.w);
        *(u32x2*)(XG + (size_t)r * D + c) = w;
        ss += __shfl_xor(ss, 16); ss += __shfl_xor(ss, 32);
        if (fq == 0) atomicAdd(ssqn + r, (u64)(ss * SSQ_FIX + 0.5f));
    }
}

__device__ __forceinline__ void skinny_inproj(const bf16_t* __restrict__ A, const bf16_t* __restrict__ Bt, bf16_t* C, int ldc, const u64* ssq, float* gate, int gate_col0, int ncb, unsigned char* lds) {
    const int tid = ltid(), wave = tid >> 6, lane = tid & 63, kq = wave & 3, fr = lane & 15, fq = lane >> 4;
    const int ntile = ncb * 8;
    for (int t0 = 0; t0 < ntile; t0 += 512) {
        const int tile = t0 + blockIdx.x * 2 + (wave >> 2);
        const int tb = tile & 7, cb = tile >> 3, row0 = TP + tb * 16, n0 = cb * 16;
        f32x4 acc0 = (f32x4){0.f, 0.f, 0.f, 0.f}, acc1 = acc0;
        if (tile < ntile) {
            const bf16_t* ap = A + (size_t)(row0 + fr) * 1024 + kq * 256 + fq * 8; const bf16_t* bp = Bt + (size_t)(n0 + fr) * 1024 + kq * 256 + fq * 8;
#pragma unroll
            for (int k0 = 0; k0 < 256; k0 += 64) {
                const bf16x8 w0 = *(const bf16x8*)(bp + k0), x0 = *(const bf16x8*)(ap + k0), w1 = *(const bf16x8*)(bp + k0 + 32), x1 = *(const bf16x8*)(ap + k0 + 32);
                acc0 = __builtin_amdgcn_mfma_f32_16x16x32_bf16(w0, x0, acc0, 0, 0, 0);
                acc1 = __builtin_amdgcn_mfma_f32_16x16x32_bf16(w1, x1, acc1, 0, 0, 0);
            }
        }
        f32x4* red = (f32x4*)lds;
        __syncthreads();
        red[wave * 64 + lane] = acc0 + acc1;
        __syncthreads();
        if (kq == 0 && tile < ntile) {
            f32x4 acc = (red[wave * 64 + lane] + red[(wave + 1) * 64 + lane]) + (red[(wave + 2) * 64 + lane] + red[(wave + 3) * 64 + lane]);
            const int r = row0 + fr, c = n0 + 4 * fq;
            acc = acc * rsqrtf((float)ssq[r] * SSQ_INV + EPS);
            u32x2 w; w.x = cvt_pk_bf16(acc.x, acc.y); w.y = cvt_pk_bf16(acc.z, acc.w);
            *(u32x2*)(C + (size_t)r * ldc + c) = w;
            if (c >= gate_col0 && c < gate_col0 + 32) *(f32x4*)(gate + (size_t)r * 32 + (c - gate_col0)) = acc;
        }
    }
}

__device__ __forceinline__ void transpose_item(const float* __restrict__ W, int K, int N, bf16_t* __restrict__ WT, int k0, int n0, int drow0, float* scr, int lane) {
    float tv[32];
#pragma unroll
    for (int i = 0; i < 32; ++i) { const int kk = 2 * i + (lane >> 5); const int n = n0 + (lane & 31); tv[i] = (n < N) ? __builtin_nontemporal_load(W + (size_t)(k0 + kk) * N + n) : 0.f; }
#pragma unroll
    for (int i = 0; i < 32; ++i) { const int kk = 2 * i + (lane >> 5); scr[kk * 33 + (lane & 31)] = tv[i]; }
    asm volatile("s_waitcnt lgkmcnt(0)" ::: "memory");
    const int c = lane & 7;
#pragma unroll
    for (int j = 0; j < 4; ++j) { const int n = (lane >> 3) + 8 * j; const float* s = scr + (8 * c) * 33 + n;
        u32x4 o; o.x = cvt_pk_bf16(s[0 * 33], s[1 * 33]); o.y = cvt_pk_bf16(s[2 * 33], s[3 * 33]); o.z = cvt_pk_bf16(s[4 * 33], s[5 * 33]); o.w = cvt_pk_bf16(s[6 * 33], s[7 * 33]);
        *(u32x4*)(WT + (size_t)(drow0 + n) * K + k0 + 8 * c) = o; }
    asm volatile("s_waitcnt lgkmcnt(0)" ::: "memory");
}

__device__ __forceinline__ void phase0(PP p, unsigned char* lds, int gw, int NGW, long gt, long GT, int lane, int wave) {
    unsigned char* ws = p->ws;
    { unsigned* ctl = (unsigned*)(ws + WS_CTL); for (long i = gt; i < 1024; i += GT) ctl[i] = 0u;
      u64* s1 = (u64*)(ws + WS_SSQ) + MP; for (long i = gt; i < 12L * MP; i += GT) s1[i] = 0ull; }
    { float* X = (float*)(ws + WS_X); bf16_t* XG = (bf16_t*)(ws + WS_XG); u64* ssq0 = (u64*)(ws + WS_SSQ); const float* g = p->in[9];
      for (int r = gw; r < MP; r += NGW) {
        if (r < T) {
            const float* src = r < TP ? p->in[0] + (size_t)r * D : p->in[1] + (size_t)(r - TP) * D;
            float ss = 0.f;
#pragma unroll
            for (int j = 0; j < 4; ++j) { const int c = (lane + 64 * j) * 4; const f32x4 v = *(const f32x4*)(src + c); *(f32x4*)(X + (size_t)r * D + c) = v; ss += dot4(v, v);
                const f32x4 t = v * *(const f32x4*)(g + c); u32x2 w; w.x = cvt_pk_bf16(t.x, t.y); w.y = cvt_pk_bf16(t.z, t.w); *(u32x2*)(XG + (size_t)r * D + c) = w; }
            ss = wave_sum(ss); if (lane == 0) ssq0[r] = (u64)(ss * SSQ_FIX + 0.5f);
        } else {
#pragma unroll
            for (int j = 0; j < 4; ++j) { const int c = (lane + 64 * j) * 4; *(f32x4*)(X + (size_t)r * D + c) = (f32x4){0.f, 0.f, 0.f, 0.f}; *(u32x2*)(XG + (size_t)r * D + c) = (u32x2){0u, 0u}; }
            if (lane == 0) ssq0[r] = 0ull;
        }
      } }
    float* scr = (float*)lds + wave * (64 * 33);
    for (int it = gw; it < 44864; it += NGW) {
        int r = it; const float* W; bf16_t* WT; int K, N, nblk, mode = 0;
        if (r < 22528) { const int isup = r >= 11264; r -= isup * 11264; const int f = r / 1408; r -= f * 1408; const int l = f >> 1, which = f & 1;
            W = (which ? (isup ? p->in[17] : p->in[16]) : (isup ? p->in[14] : p->in[13])) + (size_t)l * 1024 * 2816; K = 1024; N = 2816; nblk = 88; WT = (bf16_t*)(ws + WS_WGU + (size_t)f * SZ_WGU); mode = 1 + isup; }
        else if (r < 33792) { r -= 22528; const int f = r / 1408; r -= f * 1408; const int l = f >> 1, which = f & 1;
            W = (which ? p->in[18] : p->in[15]) + (size_t)l * 2816 * 1024; K = 2816; N = 1024; nblk = 32; WT = (bf16_t*)(ws + WS_WD + (size_t)f * SZ_WD); }
        else if (r < 36640) { r -= 33792; const int e = r / 1424; r -= e * 1424; W = p->in[19] + (size_t)e * 1024 * 2824; K = 1024; N = 2824; nblk = 89; WT = (bf16_t*)(ws + WS_WEIN + (size_t)e * SZ_WEIN); }
        else if (r < 37664) { r -= 36640; const int e = r / 512; r -= e * 512; W = p->in[20] + (size_t)e * 1024 * 1024; K = 1024; N = 1024; nblk = 32; WT = (bf16_t*)(ws + WS_WEOUT + (size_t)e * SZ_WEOUT); }
        else if (r < 42816) { r -= 37664; const int e = r / 2576; r -= e * 2576; W = p->in[26] + (size_t)e * 1024 * 5152; K = 1024; N = 5152; nblk = 161; WT = (bf16_t*)(ws + WS_WOIN + (size_t)e * SZ_WOIN); }
        else { r -= 42816; const int e = r / 1024; r -= e * 1024; W = p->in[27] + (size_t)e * 2048 * 1024; K = 2048; N = 1024; nblk = 32; WT = (bf16_t*)(ws + WS_WOOUT + (size_t)e * SZ_WOOUT); }
        const int kb = r / nblk, nb = r - kb * nblk, n0 = nb * 32, k0 = kb * 64;
        const int drow0 = mode ? ((n0 >> 7) * 256 + (n0 & 127) + (mode == 2 ? 128 : 0)) : n0;
        transpose_item(W, K, N, WT, k0, n0, drow0, scr, lane);
    }
}

__device__ __forceinline__ void even_prep(PP p, int e, int gw, int NGW, long gt, long GT, int lane) {
    unsigned char* ws = p->ws;
    const bf16_t* proj = (const bf16_t*)(ws + WS_P); const float* gate = (const float*)(ws + WS_GATE);
    float* gq = (float*)(ws + WS_U + U_GQ); float* gk = (float*)(ws + WS_U + U_GK); float* gv = (float*)(ws + WS_U + U_GV);
    float* ga = (float*)(ws + WS_U + U_GA); float* gb = (float*)(ws + WS_U + U_GB); float* gkq = (float*)(ws + WS_U + U_GKQ);
    const float* cw = p->in[22] + (size_t)e * 4 * 1536; const float* hist = p->in[4] + (size_t)e * 128 * 3 * 1536;
    for (int it = 2048 + gw; it < 2560; it += NGW) {
        const bool smp = it >= 2048;
        int b, h, t0, nt;
        if (!smp) { b = it >> 8; h = (it >> 6) & 3; t0 = (it & 63) * 32; nt = 32; } else { const int j = it - 2048; b = j >> 2; h = j & 3; t0 = 0; nt = 1; }
        const int c = lane * 2;
        f32x2 w[3][4], prev[3][3];
#pragma unroll
        for (int grp = 0; grp < 3; ++grp) {
            const int chf = grp * 512 + h * 128 + c;
#pragma unroll
            for (int i = 0; i < 4; ++i) w[grp][i] = *(const f32x2*)(cw + i * 1536 + chf);
#pragma unroll
            for (int i = 0; i < 3; ++i) {
                if (smp) prev[grp][i] = *(const f32x2*)(hist + (size_t)(b * 3 + i) * 1536 + chf);
                else { const int tt = t0 - 3 + i; if (tt >= 0) { const unsigned u = *(const unsigned*)(proj + ((size_t)b * 2048 + tt) * EINP + 768 + chf); prev[grp][i] = (f32x2){bf_lo(u), bf_hi(u)}; } else prev[grp][i] = (f32x2){0.f, 0.f}; }
            }
        }
        const float Ah = -__expf(p->in[23][e * 4 + h]), dtb = p->in[24][e * 4 + h];
#pragma unroll 4
        for (int t = 0; t < nt; ++t) {
            const size_t r = smp ? (size_t)TP + b : (size_t)b * 2048 + t0 + t;
            f32x2 val[3];
#pragma unroll
            for (int grp = 0; grp < 3; ++grp) {
                const int chf = grp * 512 + h * 128 + c;
                const unsigned u = *(const unsigned*)(proj + r * EINP + 768 + chf);
                const f32x2 cur = (f32x2){bf_lo(u), bf_hi(u)};
                const f32x2 a = (prev[grp][0] * w[grp][0] + prev[grp][1] * w[grp][1]) + (prev[grp][2] * w[grp][2] + cur * w[grp][3]);
                prev[grp][0] = prev[grp][1]; prev[grp][1] = prev[grp][2]; prev[grp][2] = cur;
                val[grp] = (f32x2){silu_f(a.x), silu_f(a.y)};
            }
            const float qn = rsqrtf(wave_sum(val[0].x * val[0].x + val[0].y * val[0].y) + EPS) * 0.08838834764831845f;
            const float kn = rsqrtf(wave_sum(val[1].x * val[1].x + val[1].y * val[1].y) + EPS);
            const f32x2 q = val[0] * qn, k = val[1] * kn;
            const float kq = wave_sum(q.x * k.x + q.y * k.y);
            const size_t o = r * 512 + h * 128 + c;
            *(f32x2*)(gq + o) = q; *(f32x2*)(gk + o) = k; *(f32x2*)(gv + o) = val[2];
            if (lane == 0) {
                const float bb = gate[r * 32 + h], aa = gate[r * 32 + 4 + h];
                const float g = Ah * softplus_f(aa + dtb);
                ga[r * 4 + h] = __expf(g); gb[r * 4 + h] = 1.f / (1.f + __expf(-bb)); gkq[r * 4 + h] = kq;
            }
        }
    }
    float* out = p->out;
    for (long i = gt; i < 131072; i += GT) { const int c = i & 127, w = (i >> 7) & 127, b = (int)(i >> 14); const size_t row = (size_t)b * 2048 + 1920 + w;
        out[O_PK + (size_t)e * 131072 + i] = bf_1(proj[row * EINP + 512 + c]); out[O_PV + (size_t)e * 131072 + i] = bf_1(proj[row * EINP + 640 + c]); }
    { const float* ck = p->in[2] + (size_t)e * 2097152; const float* cv = p->in[3] + (size_t)e * 2097152;
      for (long i = gt; i < 2097152; i += GT) { const int c = i & 127, w = (i >> 7) & 127, b = (int)(i >> 14);
        float kk, vv; if (w < 127) { kk = ck[i + 128]; vv = cv[i + 128]; } else { kk = bf_1(proj[(size_t)(TP + b) * EINP + 512 + c]); vv = bf_1(proj[(size_t)(TP + b) * EINP + 640 + c]); }
        out[O_SK + (size_t)e * 2097152 + i] = kk; out[O_SV + (size_t)e * 2097152 + i] = vv; } }
    for (long i = gt; i < 36864; i += GT) { const int ch = (int)(i % 1536), j = (int)((i / 1536) % 3), b = (int)(i / 4608);
        out[O_PGC + (size_t)e * 36864 + i] = bf_1(proj[((size_t)b * 2048 + 2045 + j) * EINP + 768 + ch]); }
    for (long i = gt; i < 589824; i += GT) { const int ch = (int)(i % 1536), j = (int)((i / 1536) % 3), b = (int)(i / 4608);
        out[O_SGC + (size_t)e * 589824 + i] = j < 2 ? hist[(size_t)(b * 3 + j + 1) * 1536 + ch] : bf_1(proj[(size_t)(TP + b) * EINP + 768 + ch]); }
}

constexpr int GR_W = 0, GR_QG = 4224, GR_U = 8448, GR_KDT = 12672, GR_AQK = 17792, GR_GL = 18432, GR_SIZE = 18688;
constexpr size_t WS_GREC = WS_P + ((size_t)128 << 20);
__device__ __forceinline__ void gdn_prep_phase(PP p, int e, unsigned char* lds) {
  unsigned char* ws = p->ws;
  const bf16_t* proj = (const bf16_t*)(ws + WS_P); const float* gate = (const float*)(ws + WS_GATE);
  const float* cw = p->in[22] + (size_t)e * 4 * 1536;
  float* qs = (float*)lds; float* ks = qs + 16 * 132; float* vs = ks + 16 * 132; float* kk = vs + 16 * 132; float* qk = kk + 16 * 17; float* Mm = qk + 16 * 17; float* gcs = Mm + 16 * 17; float* bes = gcs + 16; float* graw = bes + 16;
  const int tid = ltid(), wv = tid >> 6, lane = tid & 63;
  unsigned pu[6][4]; f32x2 pw[6][4];
#define GPREP_LOAD(s_) do { const int c_ = (s_) & 127, h_ = ((s_) >> 7) & 3, b_ = (s_) >> 9; \
    _Pragma("unroll") for (int kq_ = 0; kq_ < 6; ++kq_) { const int idx = tid + kq_ * 512; const int i = idx / 192, cp = idx - i * 192, grp = cp >> 6, cc = (cp & 63) * 2, chf = grp * 512 + h_ * 128 + cc, t = c_ * 16 + i; \
        _Pragma("unroll") for (int j = 0; j < 4; ++j) { const int tt = t - 3 + j; pu[kq_][j] = (tt >= 0) ? *(const unsigned*)(proj + ((size_t)b_ * 2048 + tt) * EINP + 768 + chf) : 0u; pw[kq_][j] = *(const f32x2*)(cw + j * 1536 + chf); } } } while (0)
  if ((int)blockIdx.x < 4096) GPREP_LOAD((int)blockIdx.x);
  for (int s = blockIdx.x; s < 4096; s += gridDim.x) {
    const int c = s & 127, h = (s >> 7) & 3, b = s >> 9, t0 = c * 16;
    unsigned char* rec = ws + WS_GREC + (size_t)s * GR_SIZE;
    bf16_t* recW = (bf16_t*)(rec + GR_W); bf16_t* recQG = (bf16_t*)(rec + GR_QG); bf16_t* recU = (bf16_t*)(rec + GR_U); bf16_t* recKDT = (bf16_t*)(rec + GR_KDT); bf16_t* recAQK = (bf16_t*)(rec + GR_AQK);
    __syncthreads();
#pragma unroll
    for (int kq_ = 0; kq_ < 6; ++kq_) {
        const int idx = tid + kq_ * 512;
        const int i = idx / 192, cp = idx - i * 192, grp = cp >> 6, cc = (cp & 63) * 2;
        f32x2 a = (f32x2){0.f, 0.f};
#pragma unroll
        for (int j = 0; j < 4; ++j) a += (f32x2){bf_lo(pu[kq_][j]), bf_hi(pu[kq_][j])} * pw[kq_][j];
        float* dst = (grp == 0 ? qs : (grp == 1 ? ks : vs)) + i * 132 + cc;
        *(f32x2*)dst = (f32x2){silu_f(a.x), silu_f(a.y)};
    }
    if (tid < 16) { const size_t r = (size_t)b * 2048 + t0 + tid; const float bb = gate[r * 32 + h], aa = gate[r * 32 + 4 + h];
        graw[tid] = -__expf(p->in[23][e * 4 + h]) * softplus_f(aa + p->in[24][e * 4 + h]); bes[tid] = 1.f / (1.f + __expf(-bb)); }
    if (s + (int)gridDim.x < 4096) GPREP_LOAD(s + (int)gridDim.x);
    __syncthreads();
#pragma unroll
    for (int k4 = 0; k4 < 4; ++k4) { const int pr = wv * 4 + k4, i = pr & 15; float* row = (pr < 16 ? qs : ks) + i * 132 + lane * 2;
        const float x0 = row[0], x1 = row[1]; const float sc = rsqrtf(wave_sum(x0 * x0 + x1 * x1) + EPS) * (pr < 16 ? 0.08838834764831845f : 1.f);
        row[0] = x0 * sc; row[1] = x1 * sc; }
    if (tid < 16) { float acc = 0.f;
#pragma unroll
        for (int i = 0; i < 16; ++i) { const float gi = graw[i]; acc += (i <= tid) ? gi : 0.f; }
        gcs[tid] = acc; }
    __syncthreads();
    if (wv < 2) {
        const int fr = lane & 15, fq = lane >> 4;
        const float* ra = (wv ? qs : ks) + fr * 132 + fq * 8; const float* rb = ks + fr * 132 + fq * 8;
        f32x4 acc = (f32x4){0.f, 0.f, 0.f, 0.f};
#pragma unroll
        for (int k4 = 0; k4 < 4; ++k4) {
            const f32x4 a0 = *(const f32x4*)(ra + k4 * 32), a1 = *(const f32x4*)(ra + k4 * 32 + 4), b0 = *(const f32x4*)(rb + k4 * 32), b1 = *(const f32x4*)(rb + k4 * 32 + 4);
            const bf16x8 af = __builtin_bit_cast(bf16x8, (u32x4){cvt_pk_bf16(a0.x, a0.y), cvt_pk_bf16(a0.z, a0.w), cvt_pk_bf16(a1.x, a1.y), cvt_pk_bf16(a1.z, a1.w)});
            const bf16x8 bg = __builtin_bit_cast(bf16x8, (u32x4){cvt_pk_bf16(b0.x, b0.y), cvt_pk_bf16(b0.z, b0.w), cvt_pk_bf16(b1.x, b1.y), cvt_pk_bf16(b1.z, b1.w)});
            acc = __builtin_amdgcn_mfma_f32_16x16x32_bf16(af, bg, acc, 0, 0, 0);
        }
        float* dstG = wv ? qk : kk;
#pragma unroll
        for (int jj = 0; jj < 4; ++jj) dstG[(4 * fq + jj) * 17 + fr] = acc[jj];
    }
    __syncthreads();
    if (tid < 256) { const int i = tid >> 4, j = tid & 15; const float dec = __expf(gcs[i] - gcs[j]);
        Mm[i * 17 + j] = (i > j) ? bes[i] * kk[i * 17 + j] * dec : 0.f;
        recAQK[i * 20 + j] = bf16_of((i >= j) ? qk[i * 17 + j] * dec : 0.f); }
    if (tid == 256) *(float*)(rec + GR_GL) = __expf(gcs[15]);
    __syncthreads();
    if (tid < 256) {
        const int cI = tid & 127, isw = tid >> 7;
        float x[16];
#pragma unroll
        for (int i = 0; i < 16; ++i) {
            float r = isw ? ks[i * 132 + cI] * bes[i] * __expf(gcs[i]) : vs[i * 132 + cI] * bes[i];
#pragma unroll
            for (int j = 0; j < i; ++j) r -= Mm[i * 17 + j] * x[j];
            x[i] = r;
            (isw ? recW : recU)[i * 132 + cI] = bf16_of(r);
        }
    } else if (tid < 384) {
        const int cI = tid - 256;
#pragma unroll
        for (int i = 0; i < 16; ++i) recQG[i * 132 + cI] = bf16_of(qs[i * 132 + cI] * __expf(gcs[i]));
    } else {
        const int dk = tid - 384; const float gl = gcs[15];
        u32x4 w0, w1;
        w0.x = cvt_pk_bf16(ks[0 * 132 + dk] * __expf(gl - gcs[0]), ks[1 * 132 + dk] * __expf(gl - gcs[1])); w0.y = cvt_pk_bf16(ks[2 * 132 + dk] * __expf(gl - gcs[2]), ks[3 * 132 + dk] * __expf(gl - gcs[3]));
        w0.z = cvt_pk_bf16(ks[4 * 132 + dk] * __expf(gl - gcs[4]), ks[5 * 132 + dk] * __expf(gl - gcs[5])); w0.w = cvt_pk_bf16(ks[6 * 132 + dk] * __expf(gl - gcs[6]), ks[7 * 132 + dk] * __expf(gl - gcs[7]));
        w1.x = cvt_pk_bf16(ks[8 * 132 + dk] * __expf(gl - gcs[8]), ks[9 * 132 + dk] * __expf(gl - gcs[9])); w1.y = cvt_pk_bf16(ks[10 * 132 + dk] * __expf(gl - gcs[10]), ks[11 * 132 + dk] * __expf(gl - gcs[11]));
        w1.z = cvt_pk_bf16(ks[12 * 132 + dk] * __expf(gl - gcs[12]), ks[13 * 132 + dk] * __expf(gl - gcs[13])); w1.w = cvt_pk_bf16(ks[14 * 132 + dk] * __expf(gl - gcs[14]), ks[15 * 132 + dk] * __expf(gl - gcs[15]));
        *(u32x2*)(recKDT + dk * 20) = (u32x2){w0.x, w0.y}; *(u32x2*)(recKDT + dk * 20 + 4) = (u32x2){w0.z, w0.w}; *(u32x2*)(recKDT + dk * 20 + 8) = (u32x2){w1.x, w1.y}; *(u32x2*)(recKDT + dk * 20 + 12) = (u32x2){w1.z, w1.w};
    }
  }
#undef GPREP_LOAD
}

__device__ __forceinline__ void gdn_chunk_scan_tile(PP p, int e, int s, unsigned char* lds) {
    unsigned char* ws = p->ws;
    float* go = (float*)(ws + WS_U + U_GO);
    const int b = s >> 2, h = s & 3;
    const unsigned char* recs = ws + WS_GREC + (size_t)s * 128 * GR_SIZE;
    const int tid = ltid(), wv = tid >> 6, lane = tid & 63, fr = lane & 15, fq = lane >> 4;
    f32x4 Sacc[8];
#pragma unroll
    for (int t = 0; t < 8; ++t) Sacc[t] = (f32x4){0.f, 0.f, 0.f, 0.f};
    u32x4 pre[4][3];
#define GREC_LOAD(k, c) do { const u32x4* src_ = (const u32x4*)(recs + (size_t)(c) * GR_SIZE); pre[k][0] = src_[tid]; pre[k][1] = src_[tid + 512]; if (tid < 144) pre[k][2] = src_[tid + 1024]; } while (0)
    GREC_LOAD(0, 0); GREC_LOAD(1, 1); GREC_LOAD(2, 2); GREC_LOAD(3, 3);
    __syncthreads();
    for (int c4 = 0; c4 < 128; c4 += 4) {
#pragma unroll
      for (int k = 0; k < 4; ++k) {
        const int c = c4 + k;
        unsigned char* buf = lds + k * GR_SIZE;
        if ((k & 1) == 0) {
            { u32x4* dst = (u32x4*)buf; dst[tid] = pre[k][0]; dst[tid + 512] = pre[k][1]; if (tid < 144) dst[tid + 1024] = pre[k][2]; }
            { u32x4* dst = (u32x4*)(buf + GR_SIZE); dst[tid] = pre[k + 1][0]; dst[tid + 512] = pre[k + 1][1]; if (tid < 144) dst[tid + 1024] = pre[k + 1][2]; }
            __syncthreads();
            if (c + 4 < 128) { GREC_LOAD(k, c + 4); GREC_LOAD(k + 1, c + 5); }
        }
        const bf16_t* W = (const bf16_t*)(buf + GR_W); const bf16_t* QG = (const bf16_t*)(buf + GR_QG); const bf16_t* U = (const bf16_t*)(buf + GR_U);
        const bf16_t* KDT = (const bf16_t*)(buf + GR_KDT); const bf16_t* AQK = (const bf16_t*)(buf + GR_AQK); const float gl = *(const float*)(buf + GR_GL);
        f32x4 aw = (f32x4){0.f, 0.f, 0.f, 0.f}, ao = aw;
#pragma unroll
        for (int ks = 0; ks < 4; ++ks) {
            u32x4 sw; sw.x = cvt_pk_bf16(Sacc[2 * ks][0], Sacc[2 * ks][1]); sw.y = cvt_pk_bf16(Sacc[2 * ks][2], Sacc[2 * ks][3]); sw.z = cvt_pk_bf16(Sacc[2 * ks + 1][0], Sacc[2 * ks + 1][1]); sw.w = cvt_pk_bf16(Sacc[2 * ks + 1][2], Sacc[2 * ks + 1][3]);
            const bf16x8 sf = __builtin_bit_cast(bf16x8, sw);
            const u32x2 wa = *(const u32x2*)(W + fr * 132 + (2 * ks) * 16 + 4 * fq), wb = *(const u32x2*)(W + fr * 132 + (2 * ks + 1) * 16 + 4 * fq);
            const u32x2 qa = *(const u32x2*)(QG + fr * 132 + (2 * ks) * 16 + 4 * fq), qb = *(const u32x2*)(QG + fr * 132 + (2 * ks + 1) * 16 + 4 * fq);
            aw = __builtin_amdgcn_mfma_f32_16x16x32_bf16(__builtin_bit_cast(bf16x8, (u32x4){wa.x, wa.y, wb.x, wb.y}), sf, aw, 0, 0, 0);
            ao = __builtin_amdgcn_mfma_f32_16x16x32_bf16(__builtin_bit_cast(bf16x8, (u32x4){qa.x, qa.y, qb.x, qb.y}), sf, ao, 0, 0, 0);
        }
        f32x4 vn;
#pragma unroll
        for (int jj = 0; jj < 4; ++jj) vn[jj] = bf_1(U[(4 * fq + jj) * 132 + wv * 16 + fr]) - aw[jj];
        const bf16x8 vf = __builtin_bit_cast(bf16x8, (u32x4){cvt_pk_bf16(vn[0], vn[1]), cvt_pk_bf16(vn[2], vn[3]), 0u, 0u});
        { const u32x2 qa = *(const u32x2*)(AQK + fr * 20 + 4 * fq);
          ao = __builtin_amdgcn_mfma_f32_16x16x32_bf16(__builtin_bit_cast(bf16x8, (u32x4){qa.x, qa.y, 0u, 0u}), vf, ao, 0, 0, 0); }
#pragma unroll
        for (int t = 0; t < 8; ++t) { const u32x2 ka = *(const u32x2*)(KDT + (t * 16 + fr) * 20 + 4 * fq);
            Sacc[t] = __builtin_amdgcn_mfma_f32_16x16x32_bf16(__builtin_bit_cast(bf16x8, (u32x4){ka.x, ka.y, 0u, 0u}), vf, Sacc[t] * gl, 0, 0, 0); }
        float* op = go + ((size_t)b * 2048 + c * 16 + 4 * fq) * 512 + h * 128 + wv * 16 + fr;
#pragma unroll
        for (int jj = 0; jj < 4; ++jj) op[jj * 512] = ao[jj];
      }
    }
#undef GREC_LOAD
    float* so = p->out + O_PGS + ((size_t)(e * 8 + b) * 4 + h) * 16384;
#pragma unroll
    for (int t = 0; t < 8; ++t)
#pragma unroll
        for (int jj = 0; jj < 4; ++jj) so[(t * 16 + 4 * fq + jj) * 128 + wv * 16 + fr] = Sacc[t][jj];
}

__device__ __forceinline__ void gdn_scan_tile(PP p, int e, int s, unsigned char* lds) {
    unsigned char* ws = p->ws;
    const float* gq = (const float*)(ws + WS_U + U_GQ); const float* gk = (const float*)(ws + WS_U + U_GK); const float* gv = (const float*)(ws + WS_U + U_GV);
    const float* ga = (const float*)(ws + WS_U + U_GA); const float* gb = (const float*)(ws + WS_U + U_GB); const float* gkq = (const float*)(ws + WS_U + U_GKQ);
    float* go = (float*)(ws + WS_U + U_GO);
    const int bh = s >> 3, cq = s & 7, b = bh >> 2, h = bh & 3, col0 = cq * 16;
    float* qs = (float*)lds; float* ks = qs + 4096; float* vs = ks + 4096; float* sc4 = vs + 512; float* os = sc4 + 128; float* dump = os + 512;
    const int tid = ltid(), w = tid >> 6, lane = tid & 63, c = lane >> 4, pp = lane & 15, mycol = (w & 3) * 4 + c;
    f32x2 S[4];
#pragma unroll
    for (int i = 0; i < 4; ++i) S[i] = (f32x2){0.f, 0.f};
    f32x4 rq[2], rk[2], rv = (f32x4){0.f, 0.f, 0.f, 0.f}; float rsc = 0.f;
#define GDN_LOAD(ck) do { const int t0_ = (ck) * 32; \
        _Pragma("unroll") for (int i = 0; i < 2; ++i) { const int idx = tid + i * 512; const size_t row = (size_t)b * 2048 + t0_ + (idx >> 5); const int c4 = idx & 31; \
            rq[i] = *(const f32x4*)(gq + row * 512 + h * 128 + c4 * 4); rk[i] = *(const f32x4*)(gk + row * 512 + h * 128 + c4 * 4); } \
        if (tid < 128) { const size_t row = (size_t)b * 2048 + t0_ + (tid >> 2); rv = *(const f32x4*)(gv + row * 512 + h * 128 + col0 + (tid & 3) * 4); } \
        else if (tid < 224) { const int j = tid - 128, which = j >> 5; const size_t row = (size_t)b * 2048 + t0_ + (j & 31); \
            rsc = (which == 0 ? ga : (which == 1 ? gb : gkq))[row * 4 + h]; } } while (0)
    GDN_LOAD(0);
    const int oidx = (pp == 0) ? mycol : (512 + (w & 3) * 64 + lane);
    for (int ck = 0; ck < 64; ++ck) {
        __syncthreads();
#pragma unroll
        for (int i = 0; i < 2; ++i) { const int idx = tid + i * 512; *(f32x4*)(qs + idx * 4) = rq[i]; *(f32x4*)(ks + idx * 4) = rk[i]; }
        if (tid < 128) *(f32x4*)(vs + tid * 4) = rv; else if (tid < 224) { const int j = tid - 128; sc4[(j & 31) * 4 + (j >> 5)] = rsc; }
        __syncthreads();
        if (ck < 63) GDN_LOAD(ck + 1);
        if (w < 4) {
            f32x4 k0 = *(const f32x4*)(ks + pp * 8), k1 = *(const f32x4*)(ks + pp * 8 + 4), q0 = *(const f32x4*)(qs + pp * 8), q1 = *(const f32x4*)(qs + pp * 8 + 4), sv = *(const f32x4*)(sc4);
            float v = vs[mycol];
#pragma unroll 4
            for (int tok = 0; tok < 32; ++tok) {
                const int tn = tok < 31 ? tok + 1 : 31;
                const f32x4 nk0 = *(const f32x4*)(ks + tn * 128 + pp * 8), nk1 = *(const f32x4*)(ks + tn * 128 + pp * 8 + 4);
                const f32x4 nq0 = *(const f32x4*)(qs + tn * 128 + pp * 8), nq1 = *(const f32x4*)(qs + tn * 128 + pp * 8 + 4);
                const f32x4 nsv = *(const f32x4*)(sc4 + tn * 4); const float nv = vs[tn * 16 + mycol];
                const float a = sv.x, bt = sv.y, kq = sv.z;
                const f32x2 kv0 = (f32x2){k0.x, k0.y}, kv1 = (f32x2){k0.z, k0.w}, kv2 = (f32x2){k1.x, k1.y}, kv3 = (f32x2){k1.z, k1.w};
                const f32x2 qv0 = (f32x2){q0.x, q0.y}, qv1 = (f32x2){q0.z, q0.w}, qv2 = (f32x2){q1.x, q1.y}, qv3 = (f32x2){q1.z, q1.w};
                const f32x2 kSv = (kv0 * S[0] + kv1 * S[1]) + (kv2 * S[2] + kv3 * S[3]);
                const f32x2 qSv = (qv0 * S[0] + qv1 * S[1]) + (qv2 * S[2] + qv3 * S[3]);
                float kS = kSv.x + kSv.y, qS = qSv.x + qSv.y;
                kS = row16_sum(kS); qS = row16_sum(qS);
                const float vn = bt * (v - a * kS); const float o = a * qS + kq * vn;
                const f32x2 a2 = (f32x2){a, a}, vn2 = (f32x2){vn, vn};
                S[0] = S[0] * a2 + kv0 * vn2; S[1] = S[1] * a2 + kv1 * vn2; S[2] = S[2] * a2 + kv2 * vn2; S[3] = S[3] * a2 + kv3 * vn2;
                os[(pp == 0 ? tok * 16 : 0) + oidx] = o;
                k0 = nk0; k1 = nk1; q0 = nq0; q1 = nq1; sv = nsv; v = nv;
            }
        }
        __syncthreads();
        if (tid < 128) { const size_t row = (size_t)b * 2048 + ck * 32 + (tid >> 2); *(f32x4*)(go + row * 512 + h * 128 + col0 + (tid & 3) * 4) = *(const f32x4*)(os + tid * 4); }
    }
#undef GDN_LOAD
    if (w < 4) {
        float* so = p->out + O_PGS + ((size_t)(e * 8 + b) * 4 + h) * 16384;
#pragma unroll
        for (int i = 0; i < 8; ++i) so[(pp * 8 + i) * 128 + col0 + mycol] = S[i >> 1][i & 1];
    }
}

__device__ __forceinline__ void attn_tile(PP p, int e, int s, unsigned char* lds) {
    unsigned char* ws = p->ws;
    const bf16_t* proj = (const bf16_t*)(ws + WS_P); bf16_t* mix = (bf16_t*)(ws + WS_MIX);
    const int b = s >> 6, qb = (s >> 1) & 31, kv = s & 1, q0 = qb * 64, kstart = q0 - 128;
    bf16_t* Ks = (bf16_t*)lds;
    bf16_t* Vt = Ks + 192 * 72;
    float* bt = (float*)(lds + (192 * 72 + 64 * 200) * 2);
    const int tid = ltid();
    __syncthreads();
#pragma unroll
    for (int i = 0; i < 3; ++i) { const int idx = tid + i * 512, slot = idx >> 3, c8 = idx & 7, pos = kstart + slot;
        u32x4 kk = (u32x4){0u, 0u, 0u, 0u}, vv = kk;
        if (pos >= 0) { const size_t row = (size_t)b * 2048 + pos; kk = *(const u32x4*)(proj + row * EINP + 512 + kv * 64 + c8 * 8); vv = *(const u32x4*)(proj + row * EINP + 640 + kv * 64 + c8 * 8); }
        *(u32x4*)(Ks + slot * 72 + c8 * 8) = kk;
        bf16_t* vp = Vt + (c8 * 8) * 200 + slot;
        vp[0] = (bf16_t)(vv.x & 0xffffu); vp[200] = (bf16_t)(vv.x >> 16); vp[400] = (bf16_t)(vv.y & 0xffffu); vp[600] = (bf16_t)(vv.y >> 16);
        vp[800] = (bf16_t)(vv.z & 0xffffu); vp[1000] = (bf16_t)(vv.z >> 16); vp[1200] = (bf16_t)(vv.w & 0xffffu); vp[1400] = (bf16_t)(vv.w >> 16); }
    for (int idx = tid; idx < 4 * 129; idx += 512) { const int g = idx / 129, d = idx - g * 129; bt[g * 132 + d] = p->in[8][t5_bucket(d) * 8 + kv * 4 + g]; }
    __syncthreads();
    const int w = tid >> 6, lane = tid & 63, g = w >> 1, qhalf = w & 1, hh = kv * 4 + g, fr = lane & 15, fq = lane >> 4;
    const float sink = p->in[21][e * 8 + hh];
    for (int qblk = 0; qblk < 2; ++qblk) {
        const int qs = qhalf * 32 + qblk * 16, kb0 = qs >> 4, qrel = qs + fr;
        const bf16_t* qp = proj + ((size_t)b * 2048 + q0 + qrel) * EINP + hh * 64 + fq * 8;
        const bf16x8 qf0 = *(const bf16x8*)(qp), qf1 = *(const bf16x8*)(qp + 32);
        float sc[10][4];
        float mx = -1e30f;
#pragma unroll
        for (int i = 0; i < 10; ++i) {
            const int kb = kb0 + i;
            if (kb < 12) {
                const bf16_t* kp = Ks + (kb * 16 + fr) * 72 + fq * 8;
                f32x4 a = (f32x4){0.f, 0.f, 0.f, 0.f};
                a = __builtin_amdgcn_mfma_f32_16x16x32_bf16(*(const bf16x8*)(kp), qf0, a, 0, 0, 0);
                a = __builtin_amdgcn_mfma_f32_16x16x32_bf16(*(const bf16x8*)(kp + 32), qf1, a, 0, 0, 0);
#pragma unroll
                for (int jj = 0; jj < 4; ++jj) { const int slot = kb * 16 + 4 * fq + jj, dd = qrel + 128 - slot;
                    const bool valid = (dd >= 0) && (dd <= 128) && (kstart + slot >= 0);
                    const int ddc = dd < 0 ? 0 : (dd > 128 ? 128 : dd);
                    const float v = valid ? a[jj] * 0.125f + bt[g * 132 + ddc] : -1e30f;
                    sc[i][jj] = v; mx = fmaxf(mx, v); }
            } else {
#pragma unroll
                for (int jj = 0; jj < 4; ++jj) sc[i][jj] = -1e30f;
            }
        }
        mx = fmaxf(mx, __shfl_xor(mx, 16)); mx = fmaxf(mx, __shfl_xor(mx, 32));
        const float m = fmaxf(mx, sink);
        float l = 0.f;
#pragma unroll
        for (int i = 0; i < 10; ++i)
#pragma unroll
            for (int jj = 0; jj < 4; ++jj) { const float pe = __expf(sc[i][jj] - m); sc[i][jj] = pe; l += pe; }
        l += __shfl_xor(l, 16); l += __shfl_xor(l, 32);
        l += __expf(sink - m);
        f32x4 o[4];
#pragma unroll
        for (int db = 0; db < 4; ++db) o[db] = (f32x4){0.f, 0.f, 0.f, 0.f};
#pragma unroll
        for (int i2 = 0; i2 < 5; ++i2) {
            const int kbA = kb0 + 2 * i2, kbB = kbA + 1;
            u32x4 pw; pw.x = cvt_pk_bf16(sc[2 * i2][0], sc[2 * i2][1]); pw.y = cvt_pk_bf16(sc[2 * i2][2], sc[2 * i2][3]);
            pw.z = cvt_pk_bf16(sc[2 * i2 + 1][0], sc[2 * i2 + 1][1]); pw.w = cvt_pk_bf16(sc[2 * i2 + 1][2], sc[2 * i2 + 1][3]);
            const bf16x8 pf = __builtin_bit_cast(bf16x8, pw);
            const int slotA = (kbA < 12 ? kbA : 11) * 16 + 4 * fq, slotB = (kbB < 12 ? kbB : 11) * 16 + 4 * fq;
#pragma unroll
            for (int db = 0; db < 4; ++db) {
                const bf16_t* vp = Vt + (db * 16 + fr) * 200;
                const u32x2 va = *(const u32x2*)(vp + slotA), vb = *(const u32x2*)(vp + slotB);
                const bf16x8 vf = __builtin_bit_cast(bf16x8, (u32x4){va.x, va.y, vb.x, vb.y});
                o[db] = __builtin_amdgcn_mfma_f32_16x16x32_bf16(vf, pf, o[db], 0, 0, 0);
            }
        }
        const float inv = 1.f / l;
        bf16_t* mp = mix + ((size_t)b * 2048 + q0 + qrel) * 1024 + hh * 64 + 4 * fq;
#pragma unroll
        for (int db = 0; db < 4; ++db) { u32x2 wv; wv.x = cvt_pk_bf16(o[db].x * inv, o[db].y * inv); wv.y = cvt_pk_bf16(o[db].z * inv, o[db].w * inv); *(u32x2*)(mp + db * 16) = wv; }
    }
}

__device__ __forceinline__ void gdn_dec_tile(PP p, int e, int s, unsigned char* lds) {
    unsigned char* ws = p->ws;
    const float* gq = (const float*)(ws + WS_U + U_GQ); const float* gk = (const float*)(ws + WS_U + U_GK); const float* gv = (const float*)(ws + WS_U + U_GV);
    const float* ga = (const float*)(ws + WS_U + U_GA); const float* gb = (const float*)(ws + WS_U + U_GB); const float* gkq = (const float*)(ws + WS_U + U_GKQ);
    float* go = (float*)(ws + WS_U + U_GO);
    const int b = s >> 2, h = s & 3, tid = ltid(), ee = tid & 127, part = tid >> 7; const size_t row = (size_t)TP + b;
    float* red = (float*)lds; float* ksh = red + 512; float* qsh = ksh + 128;
    __syncthreads();
    if (tid < 128) ksh[tid] = gk[row * 512 + h * 128 + tid]; else if (tid < 256) qsh[tid - 128] = gq[row * 512 + h * 128 + tid - 128];
    const float a = ga[row * 4 + h], bt = gb[row * 4 + h], kq = gkq[row * 4 + h], v = gv[row * 512 + h * 128 + ee];
    const float* S0 = p->in[5] + ((size_t)(e * 128 + b) * 4 + h) * 16384;
    float S[32];
#pragma unroll
    for (int i = 0; i < 32; ++i) S[i] = __builtin_nontemporal_load(S0 + (part * 32 + i) * 128 + ee);
    __syncthreads();
    float ksum = 0.f;
#pragma unroll
    for (int i = 0; i < 32; ++i) ksum += ksh[part * 32 + i] * S[i];
    red[part * 128 + ee] = ksum;
    __syncthreads();
    const float kS = (red[ee] + red[128 + ee]) + (red[256 + ee] + red[384 + ee]);
    const float vn = bt * (v - a * kS);
    float* so = p->out + O_SGS + ((size_t)(e * 128 + b) * 4 + h) * 16384;
    float qsum = 0.f;
#pragma unroll
    for (int i = 0; i < 32; ++i) { S[i] = a * S[i] + ksh[part * 32 + i] * vn; qsum += qsh[part * 32 + i] * S[i]; __builtin_nontemporal_store(S[i], so + (part * 32 + i) * 128 + ee); }
    __syncthreads();
    red[part * 128 + ee] = qsum;
    __syncthreads();
    if (part == 0) go[row * 512 + h * 128 + ee] = (red[ee] + red[128 + ee]) + (red[256 + ee] + red[384 + ee]);
    (void)kq;
}

__device__ __forceinline__ void attn_dec_tile(PP p, int e, int s, unsigned char* lds) {
    unsigned char* ws = p->ws;
    const bf16_t* proj = (const bf16_t*)(ws + WS_P); bf16_t* mix = (bf16_t*)(ws + WS_MIX);
    const int b = s, tid = ltid(), hh = tid >> 6, lane = tid & 63, kv = hh >> 2; const size_t row = (size_t)TP + b;
    float* qsh = (float*)lds + hh * 256; float* psh = qsh + 64;
    __syncthreads();
    qsh[lane] = bf_1(proj[row * EINP + hh * 64 + lane]) * 0.125f;
    asm volatile("s_waitcnt lgkmcnt(0)" ::: "memory");
    const float* Kc = p->in[2] + (size_t)(e * 128 + b) * 16384; const float* Vc = p->in[3] + (size_t)(e * 128 + b) * 16384;
    float s0 = 0.f, s1 = 0.f, s2 = 0.f;
    { const float* k0p = Kc + (lane * 2 + kv) * 64; const float* k1p = Kc + ((lane + 64) * 2 + kv) * 64; const bf16_t* k2p = proj + row * EINP + 512 + kv * 64;
#pragma unroll 4
      for (int c4 = 0; c4 < 16; ++c4) { const f32x4 qv = *(const f32x4*)(qsh + c4 * 4); s0 += dot4(qv, *(const f32x4*)(k0p + c4 * 4)); s1 += dot4(qv, *(const f32x4*)(k1p + c4 * 4)); s2 += dot4(qv, bf4(*(const u32x2*)(k2p + c4 * 4))); } }
    s0 += p->in[8][t5_bucket(128 - lane) * 8 + hh]; s1 += p->in[8][t5_bucket(64 - lane) * 8 + hh]; s2 += p->in[8][hh];
    const float sink = p->in[21][e * 8 + hh];
    const float m = fmaxf(wave_max(fmaxf(fmaxf(s0, s1), s2)), sink);
    const float p0 = __expf(s0 - m), p1 = __expf(s1 - m), p2 = __expf(s2 - m);
    const float den = wave_sum(p0 + p1) + p2 + __expf(sink - m);
    psh[lane] = p0; psh[64 + lane] = p1; if (lane == 0) psh[128] = p2;
    asm volatile("s_waitcnt lgkmcnt(0)" ::: "memory");
    float o = 0.f;
#pragma unroll 8
    for (int j = 0; j < 128; ++j) o += psh[j] * Vc[(j * 2 + kv) * 64 + lane];
    o += psh[128] * bf_1(proj[row * EINP + 640 + kv * 64 + lane]);
    o /= den;
    const float on = __shfl_down(o, 1);
    if ((lane & 1) == 0) *(unsigned*)(mix + row * 1024 + hh * 64 + lane) = cvt_pk_bf16(o, on);
}

__device__ __forceinline__ void even_post(PP p, int e, int gw, int NGW, int lane) {
    unsigned char* ws = p->ws;
    const bf16_t* proj = (const bf16_t*)(ws + WS_P); const float* go = (const float*)(ws + WS_U + U_GO); bf16_t* mix = (bf16_t*)(ws + WS_MIX);
    const float* gn = p->in[25] + e * 128;
    const int c = lane * 2;
    const f32x2 g = *(const f32x2*)(gn + c);
    for (int it0 = gw; it0 < T * 4; it0 += 4 * NGW) {
        f32x2 o[4]; unsigned zu[4]; bool ok[4];
#pragma unroll
        for (int u = 0; u < 4; ++u) { const int it = it0 + u * NGW; ok[u] = it < T * 4; const int itc = ok[u] ? it : it0; const int r = itc >> 2, h = itc & 3;
            o[u] = *(const f32x2*)(go + (size_t)r * 512 + h * 128 + c); zu[u] = *(const unsigned*)(proj + (size_t)r * EINP + 2304 + h * 128 + c); }
#pragma unroll
        for (int u = 0; u < 4; ++u) { const int it = it0 + u * NGW; const int r = it >> 2, h = it & 3;
            const float rs = rsqrtf(wave_sum(o[u].x * o[u].x + o[u].y * o[u].y) * (1.f / 128.f) + EPS);
            const f32x2 z = (f32x2){bf_lo(zu[u]), bf_hi(zu[u])};
            if (ok[u]) *(unsigned*)(mix + (size_t)r * 1024 + 512 + h * 128 + c) = cvt_pk_bf16(o[u].x * rs * g.x * silu_f(z.x), o[u].y * rs * g.y * silu_f(z.y)); }
    }
}

__device__ __forceinline__ void odd_prep(PP p, int e, long gt, long GT) {
    unsigned char* ws = p->ws;
    const bf16_t* proj = (const bf16_t*)(ws + WS_P); const float* gate = (const float*)(ws + WS_GATE);
    float* xbc = (float*)(ws + WS_U + U_XBC); float* dtb = (float*)(ws + WS_U + U_DT); float* dab = (float*)(ws + WS_U + U_DA);
    const float* cw = p->in[28] + (size_t)e * 4 * 3072; const float* cb = p->in[29] + (size_t)e * 3072; const float* hist = p->in[6] + (size_t)e * 128 * 3 * 3072;
    for (long i = gt; i < 393216 + 49152; i += GT) {
        const bool smp = i >= 393216;
        int b, t0, nt, c8;
        if (!smp) { c8 = (int)(i % 384); const int q = (int)(i / 384); t0 = (q & 127) * 16; b = q >> 7; nt = 16; } else { const int j = (int)(i - 393216); c8 = j % 384; b = j / 384; t0 = 0; nt = 1; }
        const int ch = c8 * 8;
        f32x4 w[4][2], prev[3][2];
#pragma unroll
        for (int k = 0; k < 4; ++k) { w[k][0] = *(const f32x4*)(cw + k * 3072 + ch); w[k][1] = *(const f32x4*)(cw + k * 3072 + ch + 4); }
        const f32x4 b0 = *(const f32x4*)(cb + ch), b1 = *(const f32x4*)(cb + ch + 4);
#pragma unroll
        for (int k = 0; k < 3; ++k) {
            if (smp) { prev[k][0] = *(const f32x4*)(hist + (size_t)(b * 3 + k) * 3072 + ch); prev[k][1] = *(const f32x4*)(hist + (size_t)(b * 3 + k) * 3072 + ch + 4); }
            else { const int tt = t0 - 3 + k;
                if (tt >= 0) { const u32x4 u = *(const u32x4*)(proj + ((size_t)b * 2048 + tt) * OINP + 2048 + ch); prev[k][0] = bf4((u32x2){u.x, u.y}); prev[k][1] = bf4((u32x2){u.z, u.w}); }
                else { prev[k][0] = (f32x4){0.f, 0.f, 0.f, 0.f}; prev[k][1] = prev[k][0]; } }
        }
#pragma unroll 8
        for (int t = 0; t < nt; ++t) {
            const size_t r = smp ? (size_t)TP + b : (size_t)b * 2048 + t0 + t;
            const u32x4 u = *(const u32x4*)(proj + r * OINP + 2048 + ch);
            const f32x4 c0 = bf4((u32x2){u.x, u.y}), c1 = bf4((u32x2){u.z, u.w});
            const f32x4 a0 = b0 + (prev[0][0] * w[0][0] + prev[1][0] * w[1][0]) + (prev[2][0] * w[2][0] + c0 * w[3][0]);
            const f32x4 a1 = b1 + (prev[0][1] * w[0][1] + prev[1][1] * w[1][1]) + (prev[2][1] * w[2][1] + c1 * w[3][1]);
            prev[0][0] = prev[1][0]; prev[0][1] = prev[1][1]; prev[1][0] = prev[2][0]; prev[1][1] = prev[2][1]; prev[2][0] = c0; prev[2][1] = c1;
            const f32x4 s0 = (f32x4){silu_f(a0.x), silu_f(a0.y), silu_f(a0.z), silu_f(a0.w)}, s1 = (f32x4){silu_f(a1.x), silu_f(a1.y), silu_f(a1.z), silu_f(a1.w)};
            if (smp) { *(f32x4*)(xbc + r * 3072 + ch) = s0; *(f32x4*)(xbc + r * 3072 + ch + 4) = s1; }
            else { u32x4 w8; w8.x = cvt_pk_bf16(s0.x, s0.y); w8.y = cvt_pk_bf16(s0.z, s0.w); w8.z = cvt_pk_bf16(s1.x, s1.y); w8.w = cvt_pk_bf16(s1.z, s1.w);
                   *(u32x4*)((bf16_t*)(ws + WS_U + U_XBF) + r * 3072 + ch) = w8; }
        }
    }
    for (long i = gt; i < (long)T * 32; i += GT) { const int r = (int)(i >> 5), hh = (int)(i & 31);
        const float dt = softplus_f(gate[(size_t)r * 32 + hh] + p->in[30][e * 32 + hh]); const float A = -__expf(p->in[31][e * 32 + hh]);
        dtb[i] = dt; dab[i] = __expf(dt * A); }
    float* out = p->out;
    for (long i = gt; i < 73728; i += GT) { const int ch = (int)(i % 3072), j = (int)((i / 3072) % 3), b = (int)(i / 9216);
        out[O_PSC + (size_t)e * 73728 + i] = bf_1(proj[((size_t)b * 2048 + 2045 + j) * OINP + 2048 + ch]); }
    for (long i = gt; i < 1179648; i += GT) { const int ch = (int)(i % 3072), j = (int)((i / 3072) % 3), b = (int)(i / 9216);
        out[O_SSC + (size_t)e * 1179648 + i] = j < 2 ? hist[(size_t)(b * 3 + j + 1) * 3072 + ch] : bf_1(proj[(size_t)(TP + b) * OINP + 2048 + ch]); }
}

__device__ __forceinline__ void ssd_scan_tile(PP p, int e, int s, unsigned char* lds) {
    unsigned char* ws = p->ws;
    float* xbc = (float*)(ws + WS_U + U_XBC); const float* dtb = (const float*)(ws + WS_U + U_DT); const float* dab = (const float*)(ws + WS_U + U_DA);
    const int b = s >> 5, hh = s & 31, g = hh >> 3;
    float* Bs = (float*)lds; float* Cs = Bs + 4096; float* xs = Cs + 4096; float* ys = xs + 2048; float* dts = ys + 2048;
    const int tid = ltid(), w = tid >> 6, lane = tid & 63, r_ = lane >> 4, j = lane & 15, p0 = w * 8 + r_ * 2, n0 = j * 8;
    const float Dh = p->in[32][e * 32 + hh];
    f32x2 S0[4], S1[4];
#pragma unroll
    for (int i = 0; i < 4; ++i) { S0[i] = (f32x2){0.f, 0.f}; S1[i] = (f32x2){0.f, 0.f}; }
    f32x4 rB[2], rC[2], rx; float rd = 0.f;
#define SSD_LOAD(ck) do { const int t0_ = (ck) * 32; \
        _Pragma("unroll") for (int i = 0; i < 2; ++i) { const int idx = tid + i * 512; const size_t row = (size_t)b * 2048 + t0_ + (idx >> 5); const int c4 = idx & 31; \
            rB[i] = *(const f32x4*)(xbc + row * 3072 + 2048 + g * 128 + c4 * 4); rC[i] = *(const f32x4*)(xbc + row * 3072 + 2560 + g * 128 + c4 * 4); } \
        { const size_t row = (size_t)b * 2048 + t0_ + (tid >> 4); rx = *(const f32x4*)(xbc + row * 3072 + hh * 64 + (tid & 15) * 4); } \
        if (tid < 64) { const size_t row = (size_t)b * 2048 + t0_ + (tid & 31); rd = ((tid >> 5) ? dab : dtb)[row * 32 + hh]; } } while (0)
    SSD_LOAD(0);
    for (int ck = 0; ck < 64; ++ck) {
        __syncthreads();
#pragma unroll
        for (int i = 0; i < 2; ++i) { const int idx = tid + i * 512; *(f32x4*)(Bs + idx * 4) = rB[i]; *(f32x4*)(Cs + idx * 4) = rC[i]; }
        *(f32x4*)(xs + tid * 4) = rx; if (tid < 64) dts[tid] = rd;
        __syncthreads();
        if (ck < 63) SSD_LOAD(ck + 1);
#pragma unroll 2
        for (int tok = 0; tok < 32; ++tok) {
            const float dt = dts[tok], dA = dts[32 + tok];
            const f32x2 xv = *(const f32x2*)(xs + tok * 64 + p0);
            const f32x4 B0 = *(const f32x4*)(Bs + tok * 128 + n0), B1 = *(const f32x4*)(Bs + tok * 128 + n0 + 4);
            const f32x4 C0 = *(const f32x4*)(Cs + tok * 128 + n0), C1 = *(const f32x4*)(Cs + tok * 128 + n0 + 4);
            const f32x2 xd0 = (f32x2){dt * xv.x, dt * xv.x}, xd1 = (f32x2){dt * xv.y, dt * xv.y}, dA2 = (f32x2){dA, dA};
            const f32x2 Bv[4] = {(f32x2){B0.x, B0.y}, (f32x2){B0.z, B0.w}, (f32x2){B1.x, B1.y}, (f32x2){B1.z, B1.w}};
            const f32x2 Cv[4] = {(f32x2){C0.x, C0.y}, (f32x2){C0.z, C0.w}, (f32x2){C1.x, C1.y}, (f32x2){C1.z, C1.w}};
            f32x2 y0v = (f32x2){0.f, 0.f}, y1v = (f32x2){0.f, 0.f};
#pragma unroll
            for (int i = 0; i < 4; ++i) { S0[i] = S0[i] * dA2 + xd0 * Bv[i]; S1[i] = S1[i] * dA2 + xd1 * Bv[i]; y0v += Cv[i] * S0[i]; y1v += Cv[i] * S1[i]; }
            float y0 = y0v.x + y0v.y, y1 = y1v.x + y1v.y;
            y0 = row16_sum(y0); y1 = row16_sum(y1);
            if (j == 0) *(f32x2*)(ys + tok * 64 + p0) = (f32x2){y0 + Dh * xv.x, y1 + Dh * xv.y};
        }
        __syncthreads();
        { const size_t row = (size_t)b * 2048 + ck * 32 + (tid >> 4); *(f32x4*)(xbc + row * 3072 + hh * 64 + (tid & 15) * 4) = *(const f32x4*)(ys + tid * 4); }
    }
#undef SSD_LOAD
    float* so = p->out + O_PSS + ((size_t)(e * 8 + b) * 32 + hh) * 8192;
    *(f32x4*)(so + p0 * 128 + n0) = (f32x4){S0[0].x, S0[0].y, S0[1].x, S0[1].y}; *(f32x4*)(so + p0 * 128 + n0 + 4) = (f32x4){S0[2].x, S0[2].y, S0[3].x, S0[3].y};
    *(f32x4*)(so + (p0 + 1) * 128 + n0) = (f32x4){S1[0].x, S1[0].y, S1[1].x, S1[1].y}; *(f32x4*)(so + (p0 + 1) * 128 + n0 + 4) = (f32x4){S1[2].x, S1[2].y, S1[3].x, S1[3].y};
}

__device__ __forceinline__ void ssd_chunk_tile(PP p, int e, int s, unsigned char* lds) {
    unsigned char* ws = p->ws;
    float* xbc = (float*)(ws + WS_U + U_XBC); const float* dtb = (const float*)(ws + WS_U + U_DT);
    const int b = s >> 5, hh = s & 31, g = hh >> 3;
    bf16_t* Cb = (bf16_t*)lds; bf16_t* Bb = Cb + 64 * 136; bf16_t* BT = Bb + 64 * 136; bf16_t* XT = BT + 128 * 72; bf16_t* XwT = XT + 64 * 72; bf16_t* Mb = XwT + 64 * 72; bf16_t* Sb = Mb + 64 * 72;
    float* fa = (float*)(lds + 98304);
    const int tid = ltid(), wv = tid >> 6, lane = tid & 63, fr = lane & 15, fq = lane >> 4;
    const float Ah = -__expf(p->in[31][e * 32 + hh]), Dh = p->in[32][e * 32 + hh];
    __syncthreads();
    for (int i = tid; i < 64 * 136 / 2; i += 512) ((unsigned*)Sb)[i] = 0u;
    f32x4 Sacc[4];
#pragma unroll
    for (int k = 0; k < 4; ++k) Sacc[k] = (f32x4){0.f, 0.f, 0.f, 0.f};
    const bf16_t* xbf = (const bf16_t*)(ws + WS_U + U_XBF); bf16_t* ybf = (bf16_t*)(ws + WS_U + U_YBF);
    u32x4 rB[2], rC[2], rx; float rdt = 0.f;
#define SSDC_LOAD(ck) do { const size_t r0_ = (size_t)b * 2048 + (ck) * 64; \
        _Pragma("unroll") for (int i = 0; i < 2; ++i) { const int idx = tid + i * 512; const size_t row = r0_ + (idx >> 4); const int c8 = idx & 15; \
            rB[i] = *(const u32x4*)(xbf + row * 3072 + 2048 + g * 128 + c8 * 8); rC[i] = *(const u32x4*)(xbf + row * 3072 + 2560 + g * 128 + c8 * 8); } \
        { const size_t row = r0_ + (tid >> 3); rx = *(const u32x4*)(xbf + row * 3072 + hh * 64 + (tid & 7) * 8); } \
        if (tid < 64) rdt = dtb[(r0_ + tid) * 32 + hh]; } while (0)
    SSDC_LOAD(0);
    const int pi_s = wv >> 1;
    for (int ck = 0; ck < 32; ++ck) {
        __syncthreads();
#pragma unroll
        for (int i = 0; i < 2; ++i) { const int idx = tid + i * 512, tok = idx >> 4, n8 = (idx & 15) * 8;
            *(u32x4*)(Bb + tok * 136 + n8) = rB[i]; *(u32x4*)(Cb + tok * 136 + n8) = rC[i];
            BT[(n8 + 0) * 72 + tok] = (bf16_t)(rB[i].x & 0xffffu); BT[(n8 + 1) * 72 + tok] = (bf16_t)(rB[i].x >> 16); BT[(n8 + 2) * 72 + tok] = (bf16_t)(rB[i].y & 0xffffu); BT[(n8 + 3) * 72 + tok] = (bf16_t)(rB[i].y >> 16);
            BT[(n8 + 4) * 72 + tok] = (bf16_t)(rB[i].z & 0xffffu); BT[(n8 + 5) * 72 + tok] = (bf16_t)(rB[i].z >> 16); BT[(n8 + 6) * 72 + tok] = (bf16_t)(rB[i].w & 0xffffu); BT[(n8 + 7) * 72 + tok] = (bf16_t)(rB[i].w >> 16); }
        { const int tok = tid >> 3, p8 = (tid & 7) * 8;
            XT[(p8 + 0) * 72 + tok] = (bf16_t)(rx.x & 0xffffu); XT[(p8 + 1) * 72 + tok] = (bf16_t)(rx.x >> 16); XT[(p8 + 2) * 72 + tok] = (bf16_t)(rx.y & 0xffffu); XT[(p8 + 3) * 72 + tok] = (bf16_t)(rx.y >> 16);
            XT[(p8 + 4) * 72 + tok] = (bf16_t)(rx.z & 0xffffu); XT[(p8 + 5) * 72 + tok] = (bf16_t)(rx.z >> 16); XT[(p8 + 6) * 72 + tok] = (bf16_t)(rx.w & 0xffffu); XT[(p8 + 7) * 72 + tok] = (bf16_t)(rx.w >> 16); }
        if (tid < 64) { fa[tid] = rdt * Ah; fa[256 + tid] = rdt; }
        __syncthreads();
        f32x4 gacc[2];
#pragma unroll
        for (int k = 0; k < 2; ++k) { const int tI = wv * 2 + k, li = tI >> 2, si = tI & 3;
            gacc[k] = (f32x4){0.f, 0.f, 0.f, 0.f};
            if (si <= li) {
#pragma unroll
                for (int ks = 0; ks < 4; ++ks) gacc[k] = __builtin_amdgcn_mfma_f32_16x16x32_bf16(*(const bf16x8*)(Cb + (li * 16 + fr) * 136 + ks * 32 + fq * 8), *(const bf16x8*)(Bb + (si * 16 + fr) * 136 + ks * 32 + fq * 8), gacc[k], 0, 0, 0);
            } }
        if (wv == 0) {
            float a = fa[lane];
#pragma unroll
            for (int off = 1; off < 64; off <<= 1) { const float t = __shfl_up(a, off); if (lane >= off) a += t; }
            const float last = __shfl(a, 63);
            fa[64 + lane] = a; fa[128 + lane] = __expf(last - a) * fa[256 + lane]; fa[192 + lane] = __expf(a);
            if (lane == 0) fa[320] = __expf(last);
        }
        __syncthreads();
#pragma unroll
        for (int k = 0; k < 2; ++k) { const int tI = wv * 2 + k, li = tI >> 2, si = tI & 3, sc = si * 16 + fr;
            const float as_ = fa[64 + sc], ds_ = fa[256 + sc];
#pragma unroll
            for (int jj = 0; jj < 4; ++jj) { const int l = li * 16 + 4 * fq + jj;
                const float v = (sc <= l) ? gacc[k][jj] * __expf(fa[64 + l] - as_) * ds_ : 0.f;
                Mb[l * 72 + sc] = bf16_of(v); } }
        { const int tok = tid >> 3, p8 = (tid & 7) * 8; const float ww = fa[128 + tok];
            const unsigned w0 = cvt_pk_bf16(bf_lo(rx.x) * ww, bf_hi(rx.x) * ww), w1 = cvt_pk_bf16(bf_lo(rx.y) * ww, bf_hi(rx.y) * ww), w2 = cvt_pk_bf16(bf_lo(rx.z) * ww, bf_hi(rx.z) * ww), w3 = cvt_pk_bf16(bf_lo(rx.w) * ww, bf_hi(rx.w) * ww);
            XwT[(p8 + 0) * 72 + tok] = (bf16_t)(w0 & 0xffffu); XwT[(p8 + 1) * 72 + tok] = (bf16_t)(w0 >> 16); XwT[(p8 + 2) * 72 + tok] = (bf16_t)(w1 & 0xffffu); XwT[(p8 + 3) * 72 + tok] = (bf16_t)(w1 >> 16);
            XwT[(p8 + 4) * 72 + tok] = (bf16_t)(w2 & 0xffffu); XwT[(p8 + 5) * 72 + tok] = (bf16_t)(w2 >> 16); XwT[(p8 + 6) * 72 + tok] = (bf16_t)(w3 & 0xffffu); XwT[(p8 + 7) * 72 + tok] = (bf16_t)(w3 >> 16); }
        if (ck < 31) SSDC_LOAD(ck + 1);
        __syncthreads();
#pragma unroll
        for (int k = 0; k < 2; ++k) { const int tI = wv * 2 + k, pi = tI >> 2, lj = tI & 3, l = lj * 16 + fr;
            f32x4 acc = (f32x4){0.f, 0.f, 0.f, 0.f};
#pragma unroll
            for (int ks = 0; ks < 4; ++ks) acc = __builtin_amdgcn_mfma_f32_16x16x32_bf16(*(const bf16x8*)(Sb + (pi * 16 + fr) * 136 + ks * 32 + fq * 8), *(const bf16x8*)(Cb + (lj * 16 + fr) * 136 + ks * 32 + fq * 8), acc, 0, 0, 0);
            acc = acc * fa[192 + l];
#pragma unroll
            for (int ks = 0; ks < 2; ++ks) acc = __builtin_amdgcn_mfma_f32_16x16x32_bf16(*(const bf16x8*)(XT + (pi * 16 + fr) * 72 + ks * 32 + fq * 8), *(const bf16x8*)(Mb + (lj * 16 + fr) * 72 + ks * 32 + fq * 8), acc, 0, 0, 0);
#pragma unroll
            for (int jj = 0; jj < 4; ++jj) acc[jj] += Dh * bf_1(XT[(pi * 16 + 4 * fq + jj) * 72 + l]);
            { u32x2 yw; yw.x = cvt_pk_bf16(acc[0], acc[1]); yw.y = cvt_pk_bf16(acc[2], acc[3]); *(u32x2*)(ybf + ((size_t)b * 2048 + ck * 64 + l) * 2048 + hh * 64 + pi * 16 + 4 * fq) = yw; } }
        { const float cd = fa[320];
#pragma unroll
          for (int k = 0; k < 4; ++k) { const int nj = (wv & 1) * 4 + k;
            Sacc[k] = Sacc[k] * cd;
#pragma unroll
            for (int ks = 0; ks < 2; ++ks) Sacc[k] = __builtin_amdgcn_mfma_f32_16x16x32_bf16(*(const bf16x8*)(XwT + (pi_s * 16 + fr) * 72 + ks * 32 + fq * 8), *(const bf16x8*)(BT + (nj * 16 + fr) * 72 + ks * 32 + fq * 8), Sacc[k], 0, 0, 0); } }
        __syncthreads();
#pragma unroll
        for (int k = 0; k < 4; ++k) { const int nj = (wv & 1) * 4 + k;
#pragma unroll
            for (int jj = 0; jj < 4; ++jj) Sb[(pi_s * 16 + 4 * fq + jj) * 136 + nj * 16 + fr] = bf16_of(Sacc[k][jj]); }
    }
#undef SSDC_LOAD
    float* so = p->out + O_PSS + ((size_t)(e * 8 + b) * 32 + hh) * 8192;
#pragma unroll
    for (int k = 0; k < 4; ++k) { const int nj = (wv & 1) * 4 + k;
#pragma unroll
        for (int jj = 0; jj < 4; ++jj) so[(pi_s * 16 + 4 * fq + jj) * 128 + nj * 16 + fr] = Sacc[k][jj]; }
}

__device__ __forceinline__ void ssd_dec_tile(PP p, int e, int s) {
    unsigned char* ws = p->ws;
    float* xbc = (float*)(ws + WS_U + U_XBC); const float* dtb = (const float*)(ws + WS_U + U_DT); const float* dab = (const float*)(ws + WS_U + U_DA);
    const int b = s >> 2, g = s & 3; const size_t row = (size_t)TP + b;
    const int tid = ltid(), w = tid >> 6, lane = tid & 63, r_ = lane >> 4, j = lane & 15, p0 = w * 8 + r_ * 2, n0 = j * 8;
    const f32x4 B0 = *(const f32x4*)(xbc + row * 3072 + 2048 + g * 128 + n0), B1 = *(const f32x4*)(xbc + row * 3072 + 2048 + g * 128 + n0 + 4);
    const f32x4 C0 = *(const f32x4*)(xbc + row * 3072 + 2560 + g * 128 + n0), C1 = *(const f32x4*)(xbc + row * 3072 + 2560 + g * 128 + n0 + 4);
    for (int k = 0; k < 8; ++k) {
        const int hh = g * 8 + k;
        const float dt = dtb[row * 32 + hh], dA = dab[row * 32 + hh], Dh = p->in[32][e * 32 + hh];
        const f32x2 xv = *(const f32x2*)(xbc + row * 3072 + hh * 64 + p0);
        const size_t so = ((size_t)(e * 128 + b) * 32 + hh) * 8192 + (size_t)p0 * 128 + n0;
        const float* sp = p->in[7] + so; float* op = p->out + O_SSS + so;
        f32x4 a0 = __builtin_nontemporal_load((const f32x4*)(sp)), a1 = __builtin_nontemporal_load((const f32x4*)(sp + 4)), c0 = __builtin_nontemporal_load((const f32x4*)(sp + 128)), c1 = __builtin_nontemporal_load((const f32x4*)(sp + 132));
        const float xd0 = dt * xv.x, xd1 = dt * xv.y;
        a0 = a0 * dA + B0 * xd0; a1 = a1 * dA + B1 * xd0; c0 = c0 * dA + B0 * xd1; c1 = c1 * dA + B1 * xd1;
        __builtin_nontemporal_store(a0, (f32x4*)(op)); __builtin_nontemporal_store(a1, (f32x4*)(op + 4)); __builtin_nontemporal_store(c0, (f32x4*)(op + 128)); __builtin_nontemporal_store(c1, (f32x4*)(op + 132));
        float y0 = dot4(C0, a0) + dot4(C1, a1), y1 = dot4(C0, c0) + dot4(C1, c1);
        y0 = row16_sum(y0); y1 = row16_sum(y1);
        if (j == 0) *(f32x2*)(xbc + row * 3072 + hh * 64 + p0) = (f32x2){y0 + Dh * xv.x, y1 + Dh * xv.y};
    }
}

__device__ __forceinline__ void odd_post(PP p, int e, int gw, int NGW, int lane) {
    unsigned char* ws = p->ws;
    const bf16_t* proj = (const bf16_t*)(ws + WS_P); const float* xbc = (const float*)(ws + WS_U + U_XBC); bf16_t* mix = (bf16_t*)(ws + WS_MIX);
    const bf16_t* ybf = (const bf16_t*)(ws + WS_U + U_YBF);
    const float* gn = p->in[33] + (size_t)e * 2048;
    for (int it0 = gw; it0 < TP * 4; it0 += 2 * NGW) {
        u32x4 yu[2], zu[2]; bool ok[2];
#pragma unroll
        for (int u = 0; u < 2; ++u) { const int it = it0 + u * NGW; ok[u] = it < TP * 4; const int itc = ok[u] ? it : it0; const int r = itc >> 2, ch = (itc & 3) * 512 + lane * 8;
            yu[u] = *(const u32x4*)(ybf + (size_t)r * 2048 + ch); zu[u] = *(const u32x4*)(proj + (size_t)r * OINP + ch); }
#pragma unroll
        for (int u = 0; u < 2; ++u) { const int it = it0 + u * NGW; const int r = it >> 2, ch = (it & 3) * 512 + lane * 8;
            f32x4 y0 = bf4((u32x2){yu[u].x, yu[u].y}), y1 = bf4((u32x2){yu[u].z, yu[u].w});
            const f32x4 z0 = bf4((u32x2){zu[u].x, zu[u].y}), z1 = bf4((u32x2){zu[u].z, zu[u].w});
            y0 = y0 * (f32x4){silu_f(z0.x), silu_f(z0.y), silu_f(z0.z), silu_f(z0.w)}; y1 = y1 * (f32x4){silu_f(z1.x), silu_f(z1.y), silu_f(z1.z), silu_f(z1.w)};
            const float rs = rsqrtf(wave_sum(dot4(y0, y0) + dot4(y1, y1)) * (1.f / 512.f) + EPS);
            if (ok[u]) { const f32x4 g0 = *(const f32x4*)(gn + ch), g1 = *(const f32x4*)(gn + ch + 4);
                y0 = y0 * g0 * rs; y1 = y1 * g1 * rs;
                u32x4 w; w.x = cvt_pk_bf16(y0.x, y0.y); w.y = cvt_pk_bf16(y0.z, y0.w); w.z = cvt_pk_bf16(y1.x, y1.y); w.w = cvt_pk_bf16(y1.z, y1.w);
                *(u32x4*)(mix + (size_t)r * 2048 + ch) = w; } }
    }
    for (int it = TP * 4 + gw; it < T * 4; it += NGW) {
        const int r = it >> 2, g = it & 3, ch = g * 512 + lane * 8;
        f32x4 y0 = *(const f32x4*)(xbc + (size_t)r * 3072 + ch), y1 = *(const f32x4*)(xbc + (size_t)r * 3072 + ch + 4);
        const u32x4 zu = *(const u32x4*)(proj + (size_t)r * OINP + ch); const f32x4 z0 = bf4((u32x2){zu.x, zu.y}), z1 = bf4((u32x2){zu.z, zu.w});
        y0 = y0 * (f32x4){silu_f(z0.x), silu_f(z0.y), silu_f(z0.z), silu_f(z0.w)}; y1 = y1 * (f32x4){silu_f(z1.x), silu_f(z1.y), silu_f(z1.z), silu_f(z1.w)};
        const float rs = rsqrtf(wave_sum(dot4(y0, y0) + dot4(y1, y1)) * (1.f / 512.f) + EPS);
        const f32x4 g0 = *(const f32x4*)(gn + ch), g1 = *(const f32x4*)(gn + ch + 4);
        y0 = y0 * g0 * rs; y1 = y1 * g1 * rs;
        u32x4 w; w.x = cvt_pk_bf16(y0.x, y0.y); w.y = cvt_pk_bf16(y0.z, y0.w); w.z = cvt_pk_bf16(y1.x, y1.y); w.w = cvt_pk_bf16(y1.z, y1.w);
        *(u32x4*)(mix + (size_t)r * 2048 + ch) = w;
    }
}

#define XB_TMO      128
#define XB_XCNT(j)  (256  + 64 * (j))
#define XB_XSUB(j)  (1280 + 64 * (j))
#define XB_XGEN(j)  (2304 + 64 * (j))
#define XB_TOP      3328
#define XB_TOPGEN   3392
#define XCD_BAR_WORDS 3456
#define XB_SPIN_CAP (1u << 18)
__device__ __forceinline__ unsigned xb_ld(unsigned* p)              { return __hip_atomic_load(p, __ATOMIC_RELAXED, __HIP_MEMORY_SCOPE_AGENT); }
__device__ __forceinline__ unsigned xb_add(unsigned* p, unsigned v) { return __hip_atomic_fetch_add(p, v, __ATOMIC_RELAXED, __HIP_MEMORY_SCOPE_AGENT); }
__device__ __forceinline__ unsigned xb_xcc_id() { return (unsigned)__builtin_amdgcn_s_getreg((3 << 11) | 20) & 0xFu; }
#define XB_SPIN(cond, bar) do { unsigned _sp = 0; while (cond) { __builtin_amdgcn_s_sleep(1); \
    if ((++_sp & 255u) == 0u) { if (xb_ld(&(bar)[XB_TMO])) break; if (_sp > XB_SPIN_CAP) { atomicAdd(&(bar)[XB_TMO], 1u); break; } } } } while (0)
__device__ __forceinline__ void xcd_barrier_complete(unsigned* bar, unsigned x, unsigned& nloc, unsigned& nx) {
    const unsigned G = gridDim.x * gridDim.y * gridDim.z;
    unsigned sum, cnt, mine, sp = 0u;
    for (;;) {
        sum = 0u; cnt = 0u; mine = 0u;
#pragma unroll
        for (unsigned j = 0; j < 16; ++j) { const unsigned c = xb_ld(&bar[XB_XCNT(j)]); sum += c; cnt += (c > 0u) ? 1u : 0u; mine = (j == x) ? c : mine; }
        if (sum == G) break;
        __builtin_amdgcn_s_sleep(1);
        if ((++sp & 255u) == 0u) { if (xb_ld(&bar[XB_TMO])) break; if (sp > XB_SPIN_CAP) { atomicAdd(&bar[XB_TMO], 1u); break; } }
    }
    nloc = mine > 0u ? mine : 1u; nx = cnt > 0u ? cnt : 1u;
}
__device__ __forceinline__ void xcd_barrier(unsigned* bar, volatile LAS unsigned* st) {
    asm volatile("s_waitcnt vmcnt(0)" ::: "memory");
    __syncthreads();
    if (threadIdx.x == 0) {
        const unsigned x = xb_xcc_id();
        __builtin_amdgcn_s_waitcnt(0);
        unsigned nloc = st[0], nx = st[1];
        if (nloc == 0u) { xcd_barrier_complete(bar, x, nloc, nx); st[0] = nloc; st[1] = nx; }
        const unsigned old = xb_add(&bar[XB_XSUB(x)], 1u);
        const unsigned gen = old / nloc;
        if (old + 1u == (gen + 1u) * nloc) {
            __builtin_amdgcn_fence(__ATOMIC_RELEASE, "agent");
            asm volatile("s_waitcnt vmcnt(0)" ::: "memory");
            const unsigned og = xb_add(&bar[XB_TOP], 1u);
            const unsigned tg = og / nx;
            if (og + 1u == (tg + 1u) * nx) xb_add(&bar[XB_TOPGEN], 1u);
            else XB_SPIN(xb_ld(&bar[XB_TOPGEN]) == tg, bar);
            __builtin_amdgcn_fence(__ATOMIC_ACQUIRE, "agent");
            xb_add(&bar[XB_XGEN(x)], 1u);
            asm volatile("s_waitcnt vmcnt(0)" ::: "memory");
        } else {
            XB_SPIN(xb_ld(&bar[XB_XGEN(x)]) == gen, bar);
            __builtin_amdgcn_fence(__ATOMIC_ACQUIRE, "agent");
            asm volatile("s_waitcnt vmcnt(0)" ::: "memory");
        }
    }
    __syncthreads();
}

__device__ __forceinline__ int next_tile(unsigned* ctr, unsigned char* lds) {
    int* sh = (int*)(lds + LDS_BYTES - 16);
    __syncthreads();
    if (ltid() == 0) *sh = (int)atomicAdd(ctr, 1u);
    __syncthreads();
    return *sh;
}

struct Ids { int tid, lane, wave, gw, NGW; long gt, GT; };
__device__ __forceinline__ Ids get_ids() {
    Ids I; const int tid = ltid();
    I.tid = tid; I.lane = tid & 63; I.wave = tid >> 6; I.gw = blockIdx.x * 8 + I.wave; I.NGW = gridDim.x * 8; I.gt = (long)blockIdx.x * 512 + tid; I.GT = (long)gridDim.x * 512; return I;
}
#define GSYNC() xcd_barrier((unsigned*)(get_params()->ws + WS_BAR), (volatile LAS unsigned*)((LAS unsigned char*)lds + (LDS_BYTES - 32)))

__global__ void __launch_bounds__(512, 2) mega(Params p_unused) {
    extern __shared__ __attribute__((aligned(16))) unsigned char lds[];
    { unsigned* bar0 = (unsigned*)(get_params()->ws + WS_BAR);
      if (ltid() == 0) { volatile LAS unsigned* st = (volatile LAS unsigned*)((LAS unsigned char*)lds + (LDS_BYTES - 32)); st[0] = 0u; st[1] = 0u;
        (void)xb_add(&bar0[XB_XCNT(xb_xcc_id())], 1u); } }
    __syncthreads();
    { const Ids I = get_ids(); phase0(get_params(), lds, I.gw, I.NGW, I.gt, I.GT, I.lane, I.wave); }
    GSYNC();
    if (gridDim.x == 0x7fffffffu) cg::this_grid().sync();

    for (int step = 0; step < 12; ++step) {
        const int l = step / 3, sub = step - l * 3, e = l >> 1, odd = l & 1, f = l * 2 + (sub == 2 ? 1 : 0);
        if (sub != 1) {
            unsigned char* ws = get_params()->ws;
            pg8::Gemm g{(const bf16_t*)(ws + WS_XG), (const bf16_t*)(ws + WS_WGU + (size_t)f * SZ_WGU), MP, 5632, 1024};
            pg8::EpiSwiGLU E{(bf16_t*)(ws + WS_P), (const u64*)(ws + WS_SSQ) + (size_t)(3 * l + sub) * MP};
            pg8::StaticOrder S; S.init(MP, 5632, (int)gridDim.x, (int)blockIdx.x);
            pg8::gemm_phase((LAS unsigned char*)lds, g, S, E);
            GSYNC();
        } else {
            {
                unsigned char* ws = get_params()->ws;
                pg8::Gemm g{(const bf16_t*)(ws + WS_XG), (const bf16_t*)(odd ? ws + WS_WOIN + (size_t)e * SZ_WOIN : ws + WS_WEIN + (size_t)e * SZ_WEIN), MP, odd ? OINP : EINP, 1024};
                pg8::EpiRowScale E{(bf16_t*)(ws + WS_P), odd ? OINP : EINP, (const u64*)(ws + WS_SSQ) + (size_t)(3 * l + 1) * MP, (float*)(ws + WS_GATE), odd ? 20 : 11};
                pg8::StaticOrder S; S.init(odd ? MP : TP, odd ? OINP : EINP, (int)gridDim.x, (int)blockIdx.x);
                pg8::gemm_phase((LAS unsigned char*)lds, g, S, E);
                if (!odd) skinny_inproj(g.A, g.Bt, E.C, EINP, E.ssq, E.gate, 2816, 177, lds);
            }
            GSYNC();
            if (!odd) {
                gdn_prep_phase(get_params(), e, lds);
                { const Ids I = get_ids(); even_prep(get_params(), e, I.gw, I.NGW, I.gt, I.GT, I.lane); }
                GSYNC();
                for (;;) {
                    const int t = next_tile((unsigned*)(get_params()->ws + WS_CTL) + 64 * l, lds);
                    if (t >= 1184) break;
                    if (t < 32) gdn_chunk_scan_tile(get_params(), e, t, lds);
                    else if (t < 160) attn_dec_tile(get_params(), e, t - 32, lds);
                    else if (t < 672) gdn_dec_tile(get_params(), e, t - 160, lds);
                    else attn_tile(get_params(), e, t - 672, lds);
                }
                GSYNC();
                { const Ids I = get_ids(); even_post(get_params(), e, I.gw, I.NGW, I.lane); }
                GSYNC();
            } else {
                { const Ids I = get_ids(); odd_prep(get_params(), e, I.gt, I.GT); }
                GSYNC();
                for (;;) {
                    const int t = next_tile((unsigned*)(get_params()->ws + WS_CTL) + 64 * l, lds);
                    if (t >= 768) break;
                    if (t < 256) ssd_chunk_tile(get_params(), e, t, lds);
                    else ssd_dec_tile(get_params(), e, t - 256);
                }
                GSYNC();
                { const Ids I = get_ids(); odd_post(get_params(), e, I.gw, I.NGW, I.lane); }
                GSYNC();
            }
        }
        {
            PP p = get_params(); unsigned char* ws = p->ws;
            pg8::Gemm g;
            float scale;
            if (sub != 1) { g = pg8::Gemm{(const bf16_t*)(ws + WS_P), (const bf16_t*)(ws + WS_WD + (size_t)f * SZ_WD), MP, 1024, DFF}; scale = 0.5f; }
            else { g = pg8::Gemm{(const bf16_t*)(ws + WS_MIX), (const bf16_t*)(odd ? ws + WS_WOOUT + (size_t)e * SZ_WOOUT : ws + WS_WEOUT + (size_t)e * SZ_WEOUT), MP, 1024, odd ? 2048 : 1024}; scale = 1.0f; }
            const float* gnext = sub == 0 ? p->in[10] + l * D : (sub == 1 ? p->in[11] + l * D : (l < 3 ? p->in[9] + (l + 1) * D : p->in[12]));
            pg8::EpiResidual E{(float*)(ws + WS_X), (bf16_t*)(ws + WS_XG), gnext, (u64*)(ws + WS_SSQ) + (size_t)(3 * l + sub + 1) * MP, scale};
            pg8::StaticOrder S; S.init(TP, 1024, (int)gridDim.x, (int)blockIdx.x);
            pg8::gemm_phase((LAS unsigned char*)lds, g, S, E);
            skinny_residual(g.A, g.Bt, g.K, E.X, E.XG, E.gnext, E.ssqn, E.scale, lds);
            GSYNC();
        }
    }
    { PP p = get_params(); const Ids I = get_ids(); const u64* sf = (const u64*)(p->ws + WS_SSQ) + 12ull * MP; const float* g = p->in[12]; const float* X = (const float*)(p->ws + WS_X);
      for (int r = I.gw; r < T; r += I.NGW) {
        const float rs = rsqrtf((float)sf[r] * SSQ_INV + EPS);
#pragma unroll
        for (int j = 0; j < 4; ++j) { const int c = (I.lane + 64 * j) * 4; *(f32x4*)(p->out + (size_t)r * D + c) = *(const f32x4*)(X + (size_t)r * D + c) * *(const f32x4*)(g + c) * rs; }
      } }
}

extern "C" void kernel_launch(void* const* d_in, const int* in_sizes, int n_in, void* d_out, int out_size, void* d_ws, size_t ws_size, hipStream_t stream) {
    static int grid = 0;
    if (grid == 0) {
        if (n_in != 34 || (size_t)out_size != O_END || ws_size < WS_END) { fprintf(stderr, "kernel_launch: unexpected shapes: n_in %d out %d ws %zu (need %zu)\n", n_in, out_size, ws_size, (size_t)WS_END); grid = -1; return; }
        int dev = 0, cus = 0, per_cu = 0;
        (void)hipGetDevice(&dev);
        (void)hipDeviceGetAttribute(&cus, hipDeviceAttributeMultiprocessorCount, dev);
        (void)hipFuncSetAttribute((const void*)mega, hipFuncAttributeMaxDynamicSharedMemorySize, LDS_BYTES);
        (void)hipOccupancyMaxActiveBlocksPerMultiprocessor(&per_cu, (const void*)mega, 512, LDS_BYTES);
        if (per_cu < 1) per_cu = 1;
        grid = cus * per_cu;
    }
    if (grid < 0) return;
    (void)hipMemsetAsync((unsigned char*)d_ws + WS_BAR, 0, 16384, stream);
    Params p{};
    for (int i = 0; i < 34; ++i) p.in[i] = (const float*)d_in[i];
    p.out = (float*)d_out; p.ws = (unsigned char*)d_ws;
    void* args[] = {&p};
    hipError_t e = hipLaunchCooperativeKernel((const void*)mega, dim3(grid), dim3(512), args, LDS_BYTES, stream);
    if (e != hipSuccess) fprintf(stderr, "cooperative launch failed: %s (grid %d)\n", hipGetErrorString(e), grid);
}
```

```cpp
#include <hip/hip_runtime.h>
#include <hip/hip_cooperative_groups.h>
#include <cstdio>
namespace cg = cooperative_groups;

typedef unsigned short bf16_t;
typedef short bf16x8 __attribute__((ext_vector_type(8)));
typedef float f32x4 __attribute__((ext_vector_type(4)));
typedef float f32x2 __attribute__((ext_vector_type(2)));
typedef unsigned u32x4 __attribute__((ext_vector_type(4)));
typedef unsigned u32x2 __attribute__((ext_vector_type(2)));
typedef unsigned long long u64;
#define SSQ_FIX 1048576.f
#define SSQ_INV (1.0f / (1048576.f * 1024.f))
#define LAS __attribute__((address_space(3)))

constexpr int D = 1024, TP = 16384, NSMP = 128, T = TP + NSMP, MP = 16640, DFF = 2816;
constexpr int EINP = 3072, OINP = 5376;
constexpr float EPS = 1e-6f;
constexpr int LDS_BYTES = 147456;

constexpr size_t O_YP = 0, O_YS = O_YP + 16777216ull, O_PK = O_YS + 131072ull, O_PV = O_PK + 262144ull, O_PGC = O_PV + 262144ull,
                 O_PGS = O_PGC + 73728ull, O_PSC = O_PGS + 1048576ull, O_PSS = O_PSC + 147456ull, O_SK = O_PSS + 4194304ull,
                 O_SV = O_SK + 4194304ull, O_SGC = O_SV + 4194304ull, O_SGS = O_SGC + 1179648ull, O_SSC = O_SGS + 16777216ull,
                 O_SSS = O_SSC + 2359296ull, O_END = O_SSS + 67108864ull;

constexpr size_t WS_CTL = 0, WS_SSQ = 4096;
constexpr size_t WS_WGU = (WS_SSQ + 13ull * MP * 8 + 255) & ~(size_t)255, SZ_WGU = 5632ull * 1024 * 2;
constexpr size_t WS_WD = WS_WGU + 8 * SZ_WGU, SZ_WD = 1024ull * 2816 * 2;
constexpr size_t WS_WEIN = WS_WD + 8 * SZ_WD, SZ_WEIN = 3072ull * 1024 * 2;
constexpr size_t WS_WEOUT = WS_WEIN + 2 * SZ_WEIN, SZ_WEOUT = 1024ull * 1024 * 2;
constexpr size_t WS_WOIN = WS_WEOUT + 2 * SZ_WEOUT, SZ_WOIN = 5376ull * 1024 * 2;
constexpr size_t WS_WOOUT = WS_WOIN + 2 * SZ_WOIN, SZ_WOOUT = 1024ull * 2048 * 2;
constexpr size_t WS_X = WS_WOOUT + 2 * SZ_WOOUT;
constexpr size_t WS_XG = WS_X + (size_t)MP * 1024 * 4;
constexpr size_t WS_MIX = WS_XG + (size_t)MP * 1024 * 2;
constexpr size_t WS_P = WS_MIX + (size_t)MP * 2048 * 2;
constexpr size_t WS_U = WS_P + (size_t)MP * 5376 * 4;
constexpr size_t U_XBC = 0;
constexpr size_t U_XBF = 0, U_YBF = (size_t)104 << 20;
constexpr size_t U_DT = (size_t)T * 3072 * 4;
constexpr size_t U_DA = U_DT + (size_t)T * 32 * 4;
constexpr size_t U_GQ = 0, U_GK = (size_t)T * 512 * 4, U_GV = 2 * U_GK, U_GO = 3 * U_GK, U_GA = 4 * U_GK, U_GB = U_GA + (size_t)T * 16, U_GKQ = U_GB + (size_t)T * 16;
constexpr size_t WS_GATE = WS_U + U_DA + (size_t)T * 32 * 4 + 4096;
constexpr size_t WS_BAR = WS_GATE + (size_t)MP * 32 * 4 + 4096;
constexpr size_t WS_END = WS_BAR + 16384;

struct Params { const float* in[34]; float* out; unsigned char* ws; };
__device__ __forceinline__ int ltid() { int t = threadIdx.x; asm volatile("" : "+v"(t)); return t; }
typedef const __attribute__((address_space(4))) Params* PP;
__device__ __forceinline__ PP get_params() { PP q = (PP)__builtin_amdgcn_kernarg_segment_ptr(); asm volatile("" : "+s"(q)); return q; }

__device__ __forceinline__ unsigned cvt_pk_bf16(float lo, float hi) { unsigned r; asm volatile("v_cvt_pk_bf16_f32 %0, %1, %2" : "=v"(r) : "v"(lo), "v"(hi)); return r; }
__device__ __forceinline__ float wave_max(float v) {
#pragma unroll
    for (int o = 1; o < 64; o <<= 1) v = fmaxf(v, __shfl_xor(v, o));
    return v;
}
__device__ __forceinline__ float dppf(float v, const int ctrl_unused) { return v; }
#define DPP_ADD(v, ctrl) v += __builtin_bit_cast(float, __builtin_amdgcn_update_dpp(0, __builtin_bit_cast(int, v), ctrl, 0xF, 0xF, true))
__device__ __forceinline__ float row16_sum(float v) {
    DPP_ADD(v, 0xB1); DPP_ADD(v, 0x4E); DPP_ADD(v, 0x141); DPP_ADD(v, 0x140);
    return v;
}
__device__ __forceinline__ float wave_sum(float v) {
    v = row16_sum(v);
    v += __shfl_xor(v, 16); v += __shfl_xor(v, 32);
    return v;
}
__device__ __forceinline__ float silu_f(float x) { return x / (1.f + __expf(-x)); }
__device__ __forceinline__ float softplus_f(float x) { return fmaxf(x, 0.f) + log1pf(__expf(-fabsf(x))); }
__device__ __forceinline__ int t5_bucket(int d) {
    if (d < 16) return d;
    const int large = 16 + (int)(logf((float)d * 0.0625f) / 2.0794415416798357f * 16.f);
    return large < 31 ? large : 31;
}
__device__ __forceinline__ bf16_t bf16_of(float v) { return (bf16_t)(cvt_pk_bf16(v, 0.f) & 0xffffu); }
__device__ __forceinline__ float bf_lo(unsigned w) { return __uint_as_float(w << 16); }
__device__ __forceinline__ float bf_hi(unsigned w) { return __uint_as_float(w & 0xffff0000u); }
__device__ __forceinline__ float bf_1(bf16_t b) { return __uint_as_float((unsigned)b << 16); }
__device__ __forceinline__ f32x4 bf4(u32x2 w) { return (f32x4){bf_lo(w.x), bf_hi(w.x), bf_lo(w.y), bf_hi(w.y)}; }
__device__ __forceinline__ float dot4(f32x4 a, f32x4 b) { return (a.x * b.x + a.y * b.y) + (a.z * b.z + a.w * b.w); }

namespace pg8 {
constexpr int BM = 256, BK = 64, HALF = 128, HTB = HALF * BK * 2, STAGE_BYTES = 8 * HTB, NXCD = 8, WGM = 8;
__device__ __forceinline__ int lds_byte(int r, int c) { const int st = (r >> 4) * 2 + (c >> 5), rr = r & 15, cc = c & 31, ob = rr * 64 + cc * 2; return st * 1024 + (ob ^ (((ob >> 9) & 1) << 5)); }
__device__ __forceinline__ void stage_rc(int b, int& R, int& C) { const int st = b / 1024, sb = b % 1024, swz = sb ^ (((sb >> 9) & 1) << 5); R = (st >> 1) * 16 + swz / 64; C = (st & 1) * 32 + (swz % 64) / 2; }
__device__ __forceinline__ int perm32(int rho) { const int n = rho >> 4, i = rho & 15; return 8 * (i >> 2) + 4 * n + (i & 3); }
struct Unit { int pm, pn; };
struct Gemm { const bf16_t* A; const bf16_t* Bt; int M, N, K; };
struct StaticOrder {
    int nM, nN, nwg, G, c;
    __device__ void init(int M, int N, int G_, int c_) { nM = M / BM; nN = N / BM; nwg = nM * nN; G = G_; c = c_; }
    __device__ bool next(int i, Unit& u) const {
        const long L = (long)i * G + c; if (L >= nwg) return false;
        int wgid = (int)L; { const int q = nwg / NXCD, r = nwg % NXCD, xcd = wgid % NXCD, off = wgid / NXCD; wgid = (xcd < r ? xcd * (q + 1) : r * (q + 1) + (xcd - r) * q) + off; }
        const int nig = WGM * nN, gid = wgid / nig, fm = gid * WGM, gsz = (nM - fm) < WGM ? (nM - fm) : WGM;
        u.pm = fm + ((wgid % nig) % gsz); u.pn = (wgid % nig) / gsz; return true;
    }
};

struct EpiSwiGLU {
    static constexpr bool PERM = true;
    bf16_t* H; const u64* ssq;
    __device__ __forceinline__ void operator()(const f32x4 (&acc)[2][2][4][2], const Unit& u, int wr, int wc, int fr, int fq) const {
        const int row0 = u.pm * BM + wr * 64 + fr, hid0 = u.pn * 128 + wc * 32 + 8 * fq;
        u64 sq[2][4];
#pragma unroll
        for (int ai = 0; ai < 2; ++ai)
#pragma unroll
            for (int m = 0; m < 4; ++m) sq[ai][m] = ssq[row0 + ai * HALF + m * 16];
#pragma unroll
        for (int ai = 0; ai < 2; ++ai)
#pragma unroll
            for (int m = 0; m < 4; ++m) {
                const int r = row0 + ai * HALF + m * 16;
                const float rs = rsqrtf((float)sq[ai][m] * SSQ_INV + EPS);
                float o[8];
#pragma unroll
                for (int n = 0; n < 2; ++n)
#pragma unroll
                    for (int j = 0; j < 4; ++j) { const float g = acc[ai][0][m][n][j] * rs, uu = acc[ai][1][m][n][j] * rs; o[n * 4 + j] = silu_f(g) * uu; }
                u32x4 w; w.x = cvt_pk_bf16(o[0], o[1]); w.y = cvt_pk_bf16(o[2], o[3]); w.z = cvt_pk_bf16(o[4], o[5]); w.w = cvt_pk_bf16(o[6], o[7]);
                *(u32x4*)(H + (size_t)r * DFF + hid0) = w;
            }
    }
};
struct EpiRowScale {
    static constexpr bool PERM = true;
    bf16_t* C; int ldc; const u64* ssq; float* gate; int gate_pn;
    __device__ __forceinline__ void operator()(const f32x4 (&acc)[2][2][4][2], const Unit& u, int wr, int wc, int fr, int fq) const {
        const int row0 = u.pm * BM + wr * 64 + fr, col0 = u.pn * BM + wc * 32 + 8 * fq;
        const bool dog = (u.pn == gate_pn) && (wc == 0);
        u64 sq[2][4];
#pragma unroll
        for (int ai = 0; ai < 2; ++ai)
#pragma unroll
            for (int m = 0; m < 4; ++m) sq[ai][m] = ssq[row0 + ai * HALF + m * 16];
#pragma unroll
        for (int ai = 0; ai < 2; ++ai)
#pragma unroll
            for (int m = 0; m < 4; ++m) {
                const int r = row0 + ai * HALF + m * 16;
                const float rs = rsqrtf((float)sq[ai][m] * SSQ_INV + EPS);
                bf16_t* rowp = C + (size_t)r * ldc + col0;
#pragma unroll
                for (int bj = 0; bj < 2; ++bj) { const f32x4 v0 = acc[ai][bj][m][0] * rs, v1 = acc[ai][bj][m][1] * rs;
                    u32x4 w; w.x = cvt_pk_bf16(v0.x, v0.y); w.y = cvt_pk_bf16(v0.z, v0.w); w.z = cvt_pk_bf16(v1.x, v1.y); w.w = cvt_pk_bf16(v1.z, v1.w);
                    *(u32x4*)(rowp + bj * HALF) = w; }
                if (dog) { *(f32x4*)(gate + (size_t)r * 32 + 8 * fq) = acc[ai][0][m][0] * rs; *(f32x4*)(gate + (size_t)r * 32 + 8 * fq + 4) = acc[ai][0][m][1] * rs; }
            }
    }
};
struct EpiResidual {
    static constexpr bool PERM = false;
    float* X; bf16_t* XG; const float* gnext; u64* ssqn; float scale;
    __device__ __forceinline__ void operator()(const f32x4 (&acc)[2][2][4][2], const Unit& u, int wr, int wc, int fr, int fq) const {
        const int row0 = u.pm * BM + wr * 64 + fr, col0 = u.pn * BM + wc * 32 + 4 * fq;
        f32x4 gv[2][2];
#pragma unroll
        for (int bj = 0; bj < 2; ++bj)
#pragma unroll
            for (int n = 0; n < 2; ++n) gv[bj][n] = *(const f32x4*)(gnext + col0 + bj * HALF + n * 16);
#pragma unroll
        for (int ai2 = 0; ai2 < 4; ++ai2) {
          const int ai = ai2 >> 1, mb = (ai2 & 1) * 2;
          f32x4 xin[4][2][2];
#pragma unroll
          for (int m = 0; m < 2; ++m)
#pragma unroll
              for (int bj = 0; bj < 2; ++bj)
#pragma unroll
                  for (int n = 0; n < 2; ++n) xin[mb + m][bj][n] = *(const f32x4*)(X + (size_t)(row0 + ai * HALF + (mb + m) * 16) * D + col0 + bj * HALF + n * 16);
#pragma unroll
            for (int m = mb; m < mb + 2; ++m) {
                const int r = row0 + ai * HALF + m * 16;
                float* xp = X + (size_t)r * D + col0; bf16_t* gp = XG + (size_t)r * D + col0;
                float ss = 0.f;
#pragma unroll
                for (int bj = 0; bj < 2; ++bj)
#pragma unroll
                    for (int n = 0; n < 2; ++n) {
                        f32x4 xv = xin[m][bj][n];
                        xv = xv + acc[ai][bj][m][n] * scale;
                        *(f32x4*)(xp + bj * HALF + n * 16) = xv;
                        ss += dot4(xv, xv);
                        const f32x4 t = xv * gv[bj][n];
                        u32x2 w; w.x = cvt_pk_bf16(t.x, t.y); w.y = cvt_pk_bf16(t.z, t.w);
                        *(u32x2*)(gp + bj * HALF + n * 16) = w;
                    }
                ss += __shfl_xor(ss, 16); ss += __shfl_xor(ss, 32);
                if (fq == 0) atomicAdd(ssqn + r, (u64)(ss * SSQ_FIX + 0.5f));
            }
        }
    }
};

template <class Epi>
__device__ __forceinline__ void gemm_phase(LAS unsigned char* lds, const Gemm g, const StaticOrder& S, const Epi& E) {
    const int tid = ltid(), wid = __builtin_amdgcn_readfirstlane(tid >> 6), lane = tid & 63, wr = wid >> 2, wc = wid & 3, fr = lane & 15, fq = lane >> 4;
    const int K = g.K, nt = K / BK;
    unsigned voffA[2], voffB[2];
#pragma unroll
    for (int i = 0; i < 2; ++i) { int R, C; stage_rc(tid * 16 + i * 8192, R, C); const int Rb = Epi::PERM ? ((R & ~31) + perm32(R & 31)) : R;
        voffA[i] = (unsigned)(R * K + C) * 2u; voffB[i] = (unsigned)(Rb * K + C) * 2u; }
    const size_t kstep = (size_t)(BK * 2);
    const size_t hstep = (size_t)HALF * K * 2;
    const size_t tstep = 2 * hstep;
    const unsigned ldsw = (unsigned)wid * 1024u;
    const int aoff = lds_byte(wr * 64 + fr, fq * 8), boff = lds_byte(wc * 32 + fr, fq * 8);
#define PG8_SA(b, h) (((b) * 2 + (h)) * HTB)
#define PG8_SB(b, h) ((4 + (b) * 2 + (h)) * HTB)
#define PG8_STAGE(bufoff, gbase, voff) do { _Pragma("unroll") for (int _i = 0; _i < 2; ++_i) \
        __builtin_amdgcn_global_load_lds((const unsigned*)((const char*)(gbase) + (voff)[_i]), (LAS unsigned*)(lds + (bufoff) + ldsw + _i * 8192), 16, 0, 0); } while (0)
#define PG8_LDA(dst, b, h) do { _Pragma("unroll") for (int m = 0; m < 4; ++m) _Pragma("unroll") for (int k = 0; k < 2; ++k) dst[m][k] = *(const LAS bf16x8*)(lds + PG8_SA(b, h) + aoff + m * 2048 + k * 1024); } while (0)
#define PG8_LDB(dst, b, h) do { _Pragma("unroll") for (int n = 0; n < 2; ++n) _Pragma("unroll") for (int k = 0; k < 2; ++k) dst[n][k] = *(const LAS bf16x8*)(lds + PG8_SB(b, h) + boff + n * 2048 + k * 1024); } while (0)
#define PG8_MMA(ai, bj, At, Bt) do { __builtin_amdgcn_s_setprio(1); _Pragma("unroll") for (int m = 0; m < 4; ++m) _Pragma("unroll") for (int n = 0; n < 2; ++n) _Pragma("unroll") for (int k = 0; k < 2; ++k) \
        acc[ai][bj][m][n] = __builtin_amdgcn_mfma_f32_16x16x32_bf16(Bt[n][k], At[m][k], acc[ai][bj][m][n], 0, 0, 0); __builtin_amdgcn_s_setprio(0); } while (0)
#define PG8_WAIT_V(n) asm volatile("s_waitcnt vmcnt(" #n ")" ::: "memory")
#define PG8_WAIT_L(n) asm volatile("s_waitcnt lgkmcnt(" #n ")" ::: "memory")
#define PG8_BAR __builtin_amdgcn_s_barrier()
#define PG8_SCHED __builtin_amdgcn_sched_barrier(0)
    Unit cur, nxt; int ui = 0;
    if (!S.next(0, cur)) return;
    f32x4 acc[2][2][4][2];
#pragma unroll
    for (int a = 0; a < 2; ++a)
#pragma unroll
        for (int b = 0; b < 2; ++b)
#pragma unroll
            for (int m = 0; m < 4; ++m)
#pragma unroll
                for (int n = 0; n < 2; ++n) acc[a][b][m][n] = (f32x4){0.f, 0.f, 0.f, 0.f};
    bf16x8 At[4][2], B0[2][2], B1[2][2];
    const char* cA = (const char*)g.A + (size_t)cur.pm * tstep; const char* cB = (const char*)g.Bt + (size_t)cur.pn * tstep;
    PG8_STAGE(PG8_SB(0, 0), cB, voffB); PG8_STAGE(PG8_SA(0, 0), cA, voffA); PG8_STAGE(PG8_SB(0, 1), cB + hstep, voffB); PG8_STAGE(PG8_SA(0, 1), cA + hstep, voffA);
    if (wr == 1) PG8_BAR;
    PG8_WAIT_V(4); PG8_BAR;
    PG8_STAGE(PG8_SB(1, 0), cB + kstep, voffB); PG8_STAGE(PG8_SA(1, 0), cA + kstep, voffA); PG8_STAGE(PG8_SB(1, 1), cB + hstep + kstep, voffB);
    PG8_WAIT_V(6); PG8_BAR;
    for (;;) {
        const bool has_next = S.next(ui + 1, nxt);
        const char* nA = has_next ? (const char*)g.A + (size_t)nxt.pm * tstep : cA; const char* nB = has_next ? (const char*)g.Bt + (size_t)nxt.pn * tstep : cB;
        for (int t = 0; t < nt; t += 2) {
            const bool last = (t == nt - 2);
            const char* a1 = cA + (size_t)(t + 1) * kstep;
            const char* a2 = last ? nA : cA + (size_t)(t + 2) * kstep; const char* b2 = last ? nB : cB + (size_t)(t + 2) * kstep;
            const char* a3 = a2 + kstep; const char* b3 = b2 + kstep;
            PG8_LDB(B0, 0, 0); PG8_SCHED; PG8_LDA(At, 0, 0); PG8_STAGE(PG8_SA(1, 1), a1 + hstep, voffA);
            PG8_WAIT_L(8); PG8_BAR; PG8_WAIT_L(0); PG8_MMA(0, 0, At, B0); PG8_BAR; PG8_SCHED;
            PG8_LDB(B1, 0, 1); PG8_STAGE(PG8_SB(0, 0), b2, voffB);
            PG8_BAR; PG8_WAIT_L(0); PG8_MMA(0, 1, At, B1); PG8_BAR;
            PG8_LDA(At, 0, 1); PG8_STAGE(PG8_SA(0, 0), a2, voffA);
            PG8_BAR; PG8_WAIT_L(0); PG8_MMA(1, 0, At, B0); PG8_BAR; PG8_SCHED;
            PG8_STAGE(PG8_SB(0, 1), b2 + hstep, voffB);
            PG8_WAIT_V(6); PG8_BAR; PG8_MMA(1, 1, At, B1); PG8_BAR;
            PG8_LDB(B0, 1, 0); PG8_SCHED; PG8_LDA(At, 1, 0); PG8_STAGE(PG8_SA(0, 1), a2 + hstep, voffA);
            PG8_WAIT_L(8); PG8_BAR; PG8_WAIT_L(0); PG8_MMA(0, 0, At, B0); PG8_BAR; PG8_SCHED;
            PG8_LDB(B1, 1, 1); PG8_STAGE(PG8_SB(1, 0), b3, voffB);
            PG8_BAR; PG8_WAIT_L(0); PG8_MMA(0, 1, At, B1); PG8_BAR;
            PG8_LDA(At, 1, 1); PG8_STAGE(PG8_SA(1, 0), a3, voffA);
            PG8_BAR; PG8_WAIT_L(0); PG8_MMA(1, 0, At, B0); PG8_BAR; PG8_SCHED;
            PG8_STAGE(PG8_SB(1, 1), b3 + hstep, voffB);
            PG8_WAIT_V(6); PG8_BAR; PG8_MMA(1, 1, At, B1); PG8_BAR;
        }
        E(acc, cur, wr, wc, fr, fq);
        if (!has_next) break;
#pragma unroll
        for (int a = 0; a < 2; ++a)
#pragma unroll
            for (int b = 0; b < 2; ++b)
#pragma unroll
                for (int m = 0; m < 4; ++m)
#pragma unroll
                    for (int n = 0; n < 2; ++n) acc[a][b][m][n] = (f32x4){0.f, 0.f, 0.f, 0.f};
        cur = nxt; cA = nA; cB = nB; ++ui;
    }
    PG8_WAIT_V(0);
    if (wr == 0) PG8_BAR;
    PG8_BAR;
#undef PG8_SA
#undef PG8_SB
#undef PG8_STAGE
#undef PG8_LDA
#undef PG8_LDB
#undef PG8_MMA
#undef PG8_WAIT_V
#undef PG8_WAIT_L
#undef PG8_BAR
#undef PG8_SCHED
}
}

__device__ __forceinline__ void skinny_residual(const bf16_t* __restrict__ A, const bf16_t* __restrict__ Bt, int K, float* X, bf16_t* XG, const float* gnext, u64* ssqn, float scale, unsigned char* lds) {
    const int tid = ltid(), wave = tid >> 6, lane = tid & 63, kq = wave & 3;
    const int tile = blockIdx.x * 2 + (wave >> 2);
    const int tb = tile & 7, cb = tile >> 3, row0 = TP + tb * 16, n0 = cb * 16, fr = lane & 15, fq = lane >> 4;
    const int Kq = K >> 2;
    f32x4 acc0 = (f32x4){0.f, 0.f, 0.f, 0.f}, acc1 = acc0;
    if (tile < 512) {
        const bf16_t* ap = A + (size_t)(row0 + fr) * K + kq * Kq + fq * 8; const bf16_t* bp = Bt + (size_t)(n0 + fr) * K + kq * Kq + fq * 8;
#pragma unroll 4
        for (int k0 = 0; k0 < Kq; k0 += 64) {
            const bf16x8 w0 = *(const bf16x8*)(bp + k0), x0 = *(const bf16x8*)(ap + k0), w1 = *(const bf16x8*)(bp + k0 + 32), x1 = *(const bf16x8*)(ap + k0 + 32);
            acc0 = __builtin_amdgcn_mfma_f32_16x16x32_bf16(w0, x0, acc0, 0, 0, 0);
            acc1 = __builtin_amdgcn_mfma_f32_16x16x32_bf16(w1, x1, acc1, 0, 0, 0);
        }
    }
    f32x4* red = (f32x4*)lds;
    red[wave * 64 + lane] = acc0 + acc1;
    __syncthreads();
    if (kq == 0 && tile < 512) {
        const f32x4 acc = (red[wave * 64 + lane] + red[(wave + 1) * 64 + lane]) + (red[(wave + 2) * 64 + lane] + red[(wave + 3) * 64 + lane]);
        const int r = row0 + fr, c = n0 + 4 * fq;
        f32x4 xv = *(const f32x4*)(X + (size_t)r * D + c);
        xv = xv + acc * scale;
        *(f32x4*)(X + (size_t)r * D + c) = xv;
        float ss = dot4(xv, xv);
        const f32x4 t = xv * *(const f32x4*)(gnext + c);
        u32x2 w; w.x = cvt_pk_bf16(t.x, t.y); w.y = cvt_pk_bf16(t.z, t.w);
        *(u32x2*)(XG + (size_t)r * D + c) = w;
        ss += __shfl_xor(ss, 16); ss += __shfl_xor(ss, 32);
        if (fq == 0) atomicAdd(ssqn + r, (u64)(ss * SSQ_FIX + 0.5f));
    }
}

__device__ __forceinline__ void skinny_inproj(const bf16_t* __restrict__ A, const bf16_t* __restrict__ Bt, bf16_t* C, int ldc, const u64* ssq, float* gate, int gate_col0, int ncb, unsigned char* lds) {
    const int tid = ltid(), wave = tid >> 6, lane = tid & 63, kq = wave & 3, fr = lane & 15, fq = lane >> 4;
    const int ntile = ncb * 8;
    for (int t0 = 0; t0 < ntile; t0 += 512) {
        const int tile = t0 + blockIdx.x * 2 + (wave >> 2);
        const int tb = tile & 7, cb = tile >> 3, row0 = TP + tb * 16, n0 = cb * 16;
        f32x4 acc0 = (f32x4){0.f, 0.f, 0.f, 0.f}, acc1 = acc0;
        if (tile < ntile) {
            const bf16_t* ap = A + (size_t)(row0 + fr) * 1024 + kq * 256 + fq * 8; const bf16_t* bp = Bt + (size_t)(n0 + fr) * 1024 + kq * 256 + fq * 8;
#pragma unroll
            for (int k0 = 0; k0 < 256; k0 += 64) {
                const bf16x8 w0 = *(const bf16x8*)(bp + k0), x0 = *(const bf16x8*)(ap + k0), w1 = *(const bf16x8*)(bp + k0 + 32), x1 = *(const bf16x8*)(ap + k0 + 32);
                acc0 = __builtin_amdgcn_mfma_f32_16x16x32_bf16(w0, x0, acc0, 0, 0, 0);
                acc1 = __builtin_amdgcn_mfma_f32_16x16x32_bf16(w1, x1, acc1, 0, 0, 0);
            }
        }
        f32x4* red = (f32x4*)lds;
        __syncthreads();
        red[wave * 64 + lane] = acc0 + acc1;
        __syncthreads();
        if (kq == 0 && tile < ntile) {
            f32x4 acc = (red[wave * 64 + lane] + red[(wave + 1) * 64 + lane]) + (red[(wave + 2) * 64 + lane] + red[(wave + 3) * 64 + lane]);
            const int r = row0 + fr, c = n0 + 4 * fq;
            acc = acc * rsqrtf((float)ssq[r] * SSQ_INV + EPS);
            u32x2 w; w.x = cvt_pk_bf16(acc.x, acc.y); w.y = cvt_pk_bf16(acc.z, acc.w);
            *(u32x2*)(C + (size_t)r * ldc + c) = w;
            if (c >= gate_col0 && c < gate_col0 + 32) *(f32x4*)(gate + (size_t)r * 32 + (c - gate_col0)) = acc;
        }
    }
}

__device__ __forceinline__ void transpose_item(const float* __restrict__ W, int K, int N, bf16_t* __restrict__ WT, int k0, int n0, int drow0, float* scr, int lane) {
    float tv[32];
#pragma unroll
    for (int i = 0; i < 32; ++i) { const int kk = 2 * i + (lane >> 5); const int n = n0 + (lane & 31); tv[i] = (n < N) ? __builtin_nontemporal_load(W + (size_t)(k0 + kk) * N + n) : 0.f; }
#pragma unroll
    for (int i = 0; i < 32; ++i) { const int kk = 2 * i + (lane >> 5); scr[kk * 33 + (lane & 31)] = tv[i]; }
    asm volatile("s_waitcnt lgkmcnt(0)" ::: "memory");
    const int c = lane & 7;
#pragma unroll
    for (int j = 0; j < 4; ++j) { const int n = (lane >> 3) + 8 * j; const float* s = scr + (8 * c) * 33 + n;
        u32x4 o; o.x = cvt_pk_bf16(s[0 * 33], s[1 * 33]); o.y = cvt_pk_bf16(s[2 * 33], s[3 * 33]); o.z = cvt_pk_bf16(s[4 * 33], s[5 * 33]); o.w = cvt_pk_bf16(s[6 * 33], s[7 * 33]);
        *(u32x4*)(WT + (size_t)(drow0 + n) * K + k0 + 8 * c) = o; }
    asm volatile("s_waitcnt lgkmcnt(0)" ::: "memory");
}

__device__ __forceinline__ void phase0(PP p, unsigned char* lds, int gw, int NGW, long gt, long GT, int lane, int wave) {
    unsigned char* ws = p->ws;
    { unsigned* ctl = (unsigned*)(ws + WS_CTL); for (long i = gt; i < 1024; i += GT) ctl[i] = 0u;
      u64* s1 = (u64*)(ws + WS_SSQ) + MP; for (long i = gt; i < 12L * MP; i += GT) s1[i] = 0ull; }
    { float* X = (float*)(ws + WS_X); bf16_t* XG = (bf16_t*)(ws + WS_XG); u64* ssq0 = (u64*)(ws + WS_SSQ); const float* g = p->in[9];
      for (int r = gw; r < MP; r += NGW) {
        if (r < T) {
            const float* src = r < TP ? p->in[0] + (size_t)r * D : p->in[1] + (size_t)(r - TP) * D;
            float ss = 0.f;
#pragma unroll
            for (int j = 0; j < 4; ++j) { const int c = (lane + 64 * j) * 4; const f32x4 v = *(const f32x4*)(src + c); *(f32x4*)(X + (size_t)r * D + c) = v; ss += dot4(v, v);
                const f32x4 t = v * *(const f32x4*)(g + c); u32x2 w; w.x = cvt_pk_bf16(t.x, t.y); w.y = cvt_pk_bf16(t.z, t.w); *(u32x2*)(XG + (size_t)r * D + c) = w; }
            ss = wave_sum(ss); if (lane == 0) ssq0[r] = (u64)(ss * SSQ_FIX + 0.5f);
        } else {
#pragma unroll
            for (int j = 0; j < 4; ++j) { const int c = (lane + 64 * j) * 4; *(f32x4*)(X + (size_t)r * D + c) = (f32x4){0.f, 0.f, 0.f, 0.f}; *(u32x2*)(XG + (size_t)r * D + c) = (u32x2){0u, 0u}; }
            if (lane == 0) ssq0[r] = 0ull;
        }
      } }
    float* scr = (float*)lds + wave * (64 * 33);
    for (int it = gw; it < 44864; it += NGW) {
        int r = it; const float* W; bf16_t* WT; int K, N, nblk, mode = 0;
        if (r < 22528) { const int isup = r >= 11264; r -= isup * 11264; const int f = r / 1408; r -= f * 1408; const int l = f >> 1, which = f & 1;
            W = (which ? (isup ? p->in[17] : p->in[16]) : (isup ? p->in[14] : p->in[13])) + (size_t)l * 1024 * 2816; K = 1024; N = 2816; nblk = 88; WT = (bf16_t*)(ws + WS_WGU + (size_t)f * SZ_WGU); mode = 1 + isup; }
        else if (r < 33792) { r -= 22528; const int f = r / 1408; r -= f * 1408; const int l = f >> 1, which = f & 1;
            W = (which ? p->in[18] : p->in[15]) + (size_t)l * 2816 * 1024; K = 2816; N = 1024; nblk = 32; WT = (bf16_t*)(ws + WS_WD + (size_t)f * SZ_WD); }
        else if (r < 36640) { r -= 33792; const int e = r / 1424; r -= e * 1424; W = p->in[19] + (size_t)e * 1024 * 2824; K = 1024; N = 2824; nblk = 89; WT = (bf16_t*)(ws + WS_WEIN + (size_t)e * SZ_WEIN); }
        else if (r < 37664) { r -= 36640; const int e = r / 512; r -= e * 512; W = p->in[20] + (size_t)e * 1024 * 1024; K = 1024; N = 1024; nblk = 32; WT = (bf16_t*)(ws + WS_WEOUT + (size_t)e * SZ_WEOUT); }
        else if (r < 42816) { r -= 37664; const int e = r / 2576; r -= e * 2576; W = p->in[26] + (size_t)e * 1024 * 5152; K = 1024; N = 5152; nblk = 161; WT = (bf16_t*)(ws + WS_WOIN + (size_t)e * SZ_WOIN); }
        else { r -= 42816; const int e = r / 1024; r -= e * 1024; W = p->in[27] + (size_t)e * 2048 * 1024; K = 2048; N = 1024; nblk = 32; WT = (bf16_t*)(ws + WS_WOOUT + (size_t)e * SZ_WOOUT); }
        const int kb = r / nblk, nb = r - kb * nblk, n0 = nb * 32, k0 = kb * 64;
        const int drow0 = mode ? ((n0 >> 7) * 256 + (n0 & 127) + (mode == 2 ? 128 : 0)) : n0;
        transpose_item(W, K, N, WT, k0, n0, drow0, scr, lane);
    }
}

__device__ __forceinline__ void even_prep(PP p, int e, int gw, int NGW, long gt, long GT, int lane) {
    unsigned char* ws = p->ws;
    const bf16_t* proj = (const bf16_t*)(ws + WS_P); const float* gate = (const float*)(ws + WS_GATE);
    float* gq = (float*)(ws + WS_U + U_GQ); float* gk = (float*)(ws + WS_U + U_GK); float* gv = (float*)(ws + WS_U + U_GV);
    float* ga = (float*)(ws + WS_U + U_GA); float* gb = (float*)(ws + WS_U + U_GB); float* gkq = (float*)(ws + WS_U + U_GKQ);
    const float* cw = p->in[22] + (size_t)e * 4 * 1536; const float* hist = p->in[4] + (size_t)e * 128 * 3 * 1536;
    for (int it = 2048 + gw; it < 2560; it += NGW) {
        const bool smp = it >= 2048;
        int b, h, t0, nt;
        if (!smp) { b = it >> 8; h = (it >> 6) & 3; t0 = (it & 63) * 32; nt = 32; } else { const int j = it - 2048; b = j >> 2; h = j & 3; t0 = 0; nt = 1; }
        const int c = lane * 2;
        f32x2 w[3][4], prev[3][3];
#pragma unroll
        for (int grp = 0; grp < 3; ++grp) {
            const int chf = grp * 512 + h * 128 + c;
#pragma unroll
            for (int i = 0; i < 4; ++i) w[grp][i] = *(const f32x2*)(cw + i * 1536 + chf);
#pragma unroll
            for (int i = 0; i < 3; ++i) {
                if (smp) prev[grp][i] = *(const f32x2*)(hist + (size_t)(b * 3 + i) * 1536 + chf);
                else { const int tt = t0 - 3 + i; if (tt >= 0) { const unsigned u = *(const unsigned*)(proj + ((size_t)b * 2048 + tt) * EINP + 768 + chf); prev[grp][i] = (f32x2){bf_lo(u), bf_hi(u)}; } else prev[grp][i] = (f32x2){0.f, 0.f}; }
            }
        }
        const float Ah = -__expf(p->in[23][e * 4 + h]), dtb = p->in[24][e * 4 + h];
#pragma unroll 4
        for (int t = 0; t < nt; ++t) {
            const size_t r = smp ? (size_t)TP + b : (size_t)b * 2048 + t0 + t;
            f32x2 val[3];
#pragma unroll
            for (int grp = 0; grp < 3; ++grp) {
                const int chf = grp * 512 + h * 128 + c;
                const unsigned u = *(const unsigned*)(proj + r * EINP + 768 + chf);
                const f32x2 cur = (f32x2){bf_lo(u), bf_hi(u)};
                const f32x2 a = (prev[grp][0] * w[grp][0] + prev[grp][1] * w[grp][1]) + (prev[grp][2] * w[grp][2] + cur * w[grp][3]);
                prev[grp][0] = prev[grp][1]; prev[grp][1] = prev[grp][2]; prev[grp][2] = cur;
                val[grp] = (f32x2){silu_f(a.x), silu_f(a.y)};
            }
            const float qn = rsqrtf(wave_sum(val[0].x * val[0].x + val[0].y * val[0].y) + EPS) * 0.08838834764831845f;
            const float kn = rsqrtf(wave_sum(val[1].x * val[1].x + val[1].y * val[1].y) + EPS);
            const f32x2 q = val[0] * qn, k = val[1] * kn;
            const float kq = wave_sum(q.x * k.x + q.y * k.y);
            const size_t o = r * 512 + h * 128 + c;
            *(f32x2*)(gq + o) = q; *(f32x2*)(gk + o) = k; *(f32x2*)(gv + o) = val[2];
            if (lane == 0) {
                const float bb = gate[r * 32 + h], aa = gate[r * 32 + 4 + h];
                const float g = Ah * softplus_f(aa + dtb);
                ga[r * 4 + h] = __expf(g); gb[r * 4 + h] = 1.f / (1.f + __expf(-bb)); gkq[r * 4 + h] = kq;
            }
        }
    }
    float* out = p->out;
    for (long i = gt; i < 131072; i += GT) { const int c = i & 127, w = (i >> 7) & 127, b = (int)(i >> 14); const size_t row = (size_t)b * 2048 + 1920 + w;
        out[O_PK + (size_t)e * 131072 + i] = bf_1(proj[row * EINP + 512 + c]); out[O_PV + (size_t)e * 131072 + i] = bf_1(proj[row * EINP + 640 + c]); }
    { const float* ck = p->in[2] + (size_t)e * 2097152; const float* cv = p->in[3] + (size_t)e * 2097152;
      for (long i = gt; i < 2097152; i += GT) { const int c = i & 127, w = (i >> 7) & 127, b = (int)(i >> 14);
        float kk, vv; if (w < 127) { kk = ck[i + 128]; vv = cv[i + 128]; } else { kk = bf_1(proj[(size_t)(TP + b) * EINP + 512 + c]); vv = bf_1(proj[(size_t)(TP + b) * EINP + 640 + c]); }
        out[O_SK + (size_t)e * 2097152 + i] = kk; out[O_SV + (size_t)e * 2097152 + i] = vv; } }
    for (long i = gt; i < 36864; i += GT) { const int ch = (int)(i % 1536), j = (int)((i / 1536) % 3), b = (int)(i / 4608);
        out[O_PGC + (size_t)e * 36864 + i] = bf_1(proj[((size_t)b * 2048 + 2045 + j) * EINP + 768 + ch]); }
    for (long i = gt; i < 589824; i += GT) { const int ch = (int)(i % 1536), j = (int)((i / 1536) % 3), b = (int)(i / 4608);
        out[O_SGC + (size_t)e * 589824 + i] = j < 2 ? hist[(size_t)(b * 3 + j + 1) * 1536 + ch] : bf_1(proj[(size_t)(TP + b) * EINP + 768 + ch]); }
}

constexpr int GR_W = 0, GR_QG = 4224, GR_U = 8448, GR_KDT = 12672, GR_AQK = 17792, GR_GL = 18432, GR_SIZE = 18688;
constexpr size_t WS_GREC = WS_P + ((size_t)128 << 20);
__device__ __forceinline__ void gdn_prep_phase(PP p, int e, unsigned char* lds) {
  unsigned char* ws = p->ws;
  const bf16_t* proj = (const bf16_t*)(ws + WS_P); const float* gate = (const float*)(ws + WS_GATE);
  const float* cw = p->in[22] + (size_t)e * 4 * 1536;
  float* qs = (float*)lds; float* ks = qs + 16 * 132; float* vs = ks + 16 * 132; float* kk = vs + 16 * 132; float* qk = kk + 16 * 17; float* Mm = qk + 16 * 17; float* gcs = Mm + 16 * 17; float* bes = gcs + 16; float* graw = bes + 16;
  const int tid = ltid(), wv = tid >> 6, lane = tid & 63;
  unsigned pu[6][4]; f32x2 pw[6][4];
#define GPREP_LOAD(s_) do { const int c_ = (s_) & 127, h_ = ((s_) >> 7) & 3, b_ = (s_) >> 9; \
    _Pragma("unroll") for (int kq_ = 0; kq_ < 6; ++kq_) { const int idx = tid + kq_ * 512; const int i = idx / 192, cp = idx - i * 192, grp = cp >> 6, cc = (cp & 63) * 2, chf = grp * 512 + h_ * 128 + cc, t = c_ * 16 + i; \
        _Pragma("unroll") for (int j = 0; j < 4; ++j) { const int tt = t - 3 + j; pu[kq_][j] = (tt >= 0) ? *(const unsigned*)(proj + ((size_t)b_ * 2048 + tt) * EINP + 768 + chf) : 0u; pw[kq_][j] = *(const f32x2*)(cw + j * 1536 + chf); } } } while (0)
  if ((int)blockIdx.x < 4096) GPREP_LOAD((int)blockIdx.x);
  for (int s = blockIdx.x; s < 4096; s += gridDim.x) {
    const int c = s & 127, h = (s >> 7) & 3, b = s >> 9, t0 = c * 16;
    unsigned char* rec = ws + WS_GREC + (size_t)s * GR_SIZE;
    bf16_t* recW = (bf16_t*)(rec + GR_W); bf16_t* recQG = (bf16_t*)(rec + GR_QG); bf16_t* recU = (bf16_t*)(rec + GR_U); bf16_t* recKDT = (bf16_t*)(rec + GR_KDT); bf16_t* recAQK = (bf16_t*)(rec + GR_AQK);
    __syncthreads();
#pragma unroll
    for (int kq_ = 0; kq_ < 6; ++kq_) {
        const int idx = tid + kq_ * 512;
        const int i = idx / 192, cp = idx - i * 192, grp = cp >> 6, cc = (cp & 63) * 2;
        f32x2 a = (f32x2){0.f, 0.f};
#pragma unroll
        for (int j = 0; j < 4; ++j) a += (f32x2){bf_lo(pu[kq_][j]), bf_hi(pu[kq_][j])} * pw[kq_][j];
        float* dst = (grp == 0 ? qs : (grp == 1 ? ks : vs)) + i * 132 + cc;
        *(f32x2*)dst = (f32x2){silu_f(a.x), silu_f(a.y)};
    }
    if (tid < 16) { const size_t r = (size_t)b * 2048 + t0 + tid; const float bb = gate[r * 32 + h], aa = gate[r * 32 + 4 + h];
        graw[tid] = -__expf(p->in[23][e * 4 + h]) * softplus_f(aa + p->in[24][e * 4 + h]); bes[tid] = 1.f / (1.f + __expf(-bb)); }
    if (s + (int)gridDim.x < 4096) GPREP_LOAD(s + (int)gridDim.x);
    __syncthreads();
#pragma unroll
    for (int k4 = 0; k4 < 4; ++k4) { const int pr = wv * 4 + k4, i = pr & 15; float* row = (pr < 16 ? qs : ks) + i * 132 + lane * 2;
        const float x0 = row[0], x1 = row[1]; const float sc = rsqrtf(wave_sum(x0 * x0 + x1 * x1) + EPS) * (pr < 16 ? 0.08838834764831845f : 1.f);
        row[0] = x0 * sc; row[1] = x1 * sc; }
    if (tid < 16) { float acc = 0.f;
#pragma unroll
        for (int i = 0; i < 16; ++i) { const float gi = graw[i]; acc += (i <= tid) ? gi : 0.f; }
        gcs[tid] = acc; }
    __syncthreads();
    if (wv < 2) {
        const int fr = lane & 15, fq = lane >> 4;
        const float* ra = (wv ? qs : ks) + fr * 132 + fq * 8; const float* rb = ks + fr * 132 + fq * 8;
        f32x4 acc = (f32x4){0.f, 0.f, 0.f, 0.f};
#pragma unroll
        for (int k4 = 0; k4 < 4; ++k4) {
            const f32x4 a0 = *(const f32x4*)(ra + k4 * 32), a1 = *(const f32x4*)(ra + k4 * 32 + 4), b0 = *(const f32x4*)(rb + k4 * 32), b1 = *(const f32x4*)(rb + k4 * 32 + 4);
            const bf16x8 af = __builtin_bit_cast(bf16x8, (u32x4){cvt_pk_bf16(a0.x, a0.y), cvt_pk_bf16(a0.z, a0.w), cvt_pk_bf16(a1.x, a1.y), cvt_pk_bf16(a1.z, a1.w)});
            const bf16x8 bg = __builtin_bit_cast(bf16x8, (u32x4){cvt_pk_bf16(b0.x, b0.y), cvt_pk_bf16(b0.z, b0.w), cvt_pk_bf16(b1.x, b1.y), cvt_pk_bf16(b1.z, b1.w)});
            acc = __builtin_amdgcn_mfma_f32_16x16x32_bf16(af, bg, acc, 0, 0, 0);
        }
        float* dstG = wv ? qk : kk;
#pragma unroll
        for (int jj = 0; jj < 4; ++jj) dstG[(4 * fq + jj) * 17 + fr] = acc[jj];
    }
    __syncthreads();
    if (tid < 256) { const int i = tid >> 4, j = tid & 15; const float dec = __expf(gcs[i] - gcs[j]);
        Mm[i * 17 + j] = (i > j) ? bes[i] * kk[i * 17 + j] * dec : 0.f;
        recAQK[i * 20 + j] = bf16_of((i >= j) ? qk[i * 17 + j] * dec : 0.f); }
    if (tid == 256) *(float*)(rec + GR_GL) = __expf(gcs[15]);
    __syncthreads();
    if (tid < 256) {
        const int cI = tid & 127, isw = tid >> 7;
        float x[16];
#pragma unroll
        for (int i = 0; i < 16; ++i) {
            float r = isw ? ks[i * 132 + cI] * bes[i] * __expf(gcs[i]) : vs[i * 132 + cI] * bes[i];
#pragma unroll
            for (int j = 0; j < i; ++j) r -= Mm[i * 17 + j] * x[j];
            x[i] = r;
            (isw ? recW : recU)[i * 132 + cI] = bf16_of(r);
        }
    } else if (tid < 384) {
        const int cI = tid - 256;
#pragma unroll
        for (int i = 0; i < 16; ++i) recQG[i * 132 + cI] = bf16_of(qs[i * 132 + cI] * __expf(gcs[i]));
    } else {
        const int dk = tid - 384; const float gl = gcs[15];
        u32x4 w0, w1;
        w0.x = cvt_pk_bf16(ks[0 * 132 + dk] * __expf(gl - gcs[0]), ks[1 * 132 + dk] * __expf(gl - gcs[1])); w0.y = cvt_pk_bf16(ks[2 * 132 + dk] * __expf(gl - gcs[2]), ks[3 * 132 + dk] * __expf(gl - gcs[3]));
        w0.z = cvt_pk_bf16(ks[4 * 132 + dk] * __expf(gl - gcs[4]), ks[5 * 132 + dk] * __expf(gl - gcs[5])); w0.w = cvt_pk_bf16(ks[6 * 132 + dk] * __expf(gl - gcs[6]), ks[7 * 132 + dk] * __expf(gl - gcs[7]));
        w1.x = cvt_pk_bf16(ks[8 * 132 + dk] * __expf(gl - gcs[8]), ks[9 * 132 + dk] * __expf(gl - gcs[9])); w1.y = cvt_pk_bf16(ks[10 * 132 + dk] * __expf(gl - gcs[10]), ks[11 * 132 + dk] * __expf(gl - gcs[11]));
        w1.z = cvt_pk_bf16(ks[12 * 132 + dk] * __expf(gl - gcs[12]), ks[13 * 132 + dk] * __expf(gl - gcs[13])); w1.w = cvt_pk_bf16(ks[14 * 132 + dk] * __expf(gl - gcs[14]), ks[15 * 132 + dk] * __expf(gl - gcs[15]));
        *(u32x2*)(recKDT + dk * 20) = (u32x2){w0.x, w0.y}; *(u32x2*)(recKDT + dk * 20 + 4) = (u32x2){w0.z, w0.w}; *(u32x2*)(recKDT + dk * 20 + 8) = (u32x2){w1.x, w1.y}; *(u32x2*)(recKDT + dk * 20 + 12) = (u32x2){w1.z, w1.w};
    }
  }
#undef GPREP_LOAD
}

__device__ __forceinline__ void gdn_chunk_scan_tile(PP p, int e, int s, unsigned char* lds) {
    unsigned char* ws = p->ws;
    float* go = (float*)(ws + WS_U + U_GO);
    const int b = s >> 2, h = s & 3;
    const unsigned char* recs = ws + WS_GREC + (size_t)s * 128 * GR_SIZE;
    const int tid = ltid(), wv = tid >> 6, lane = tid & 63, fr = lane & 15, fq = lane >> 4;
    f32x4 Sacc[8];
#pragma unroll
    for (int t = 0; t < 8; ++t) Sacc[t] = (f32x4){0.f, 0.f, 0.f, 0.f};
    u32x4 pre[4][3];
#define GREC_LOAD(k, c) do { const u32x4* src_ = (const u32x4*)(recs + (size_t)(c) * GR_SIZE); pre[k][0] = src_[tid]; pre[k][1] = src_[tid + 512]; if (tid < 144) pre[k][2] = src_[tid + 1024]; } while (0)
    GREC_LOAD(0, 0); GREC_LOAD(1, 1); GREC_LOAD(2, 2); GREC_LOAD(3, 3);
    __syncthreads();
    for (int c4 = 0; c4 < 128; c4 += 4) {
#pragma unroll
      for (int k = 0; k < 4; ++k) {
        const int c = c4 + k;
        unsigned char* buf = lds + k * GR_SIZE;
        if ((k & 1) == 0) {
            { u32x4* dst = (u32x4*)buf; dst[tid] = pre[k][0]; dst[tid + 512] = pre[k][1]; if (tid < 144) dst[tid + 1024] = pre[k][2]; }
            { u32x4* dst = (u32x4*)(buf + GR_SIZE); dst[tid] = pre[k + 1][0]; dst[tid + 512] = pre[k + 1][1]; if (tid < 144) dst[tid + 1024] = pre[k + 1][2]; }
            __syncthreads();
            if (c + 4 < 128) { GREC_LOAD(k, c + 4); GREC_LOAD(k + 1, c + 5); }
        }
        const bf16_t* W = (const bf16_t*)(buf + GR_W); const bf16_t* QG = (const bf16_t*)(buf + GR_QG); const bf16_t* U = (const bf16_t*)(buf + GR_U);
        const bf16_t* KDT = (const bf16_t*)(buf + GR_KDT); const bf16_t* AQK = (const bf16_t*)(buf + GR_AQK); const float gl = *(const float*)(buf + GR_GL);
        f32x4 aw = (f32x4){0.f, 0.f, 0.f, 0.f}, ao = aw;
#pragma unroll
        for (int ks = 0; ks < 4; ++ks) {
            u32x4 sw; sw.x = cvt_pk_bf16(Sacc[2 * ks][0], Sacc[2 * ks][1]); sw.y = cvt_pk_bf16(Sacc[2 * ks][2], Sacc[2 * ks][3]); sw.z = cvt_pk_bf16(Sacc[2 * ks + 1][0], Sacc[2 * ks + 1][1]); sw.w = cvt_pk_bf16(Sacc[2 * ks + 1][2], Sacc[2 * ks + 1][3]);
            const bf16x8 sf = __builtin_bit_cast(bf16x8, sw);
            const u32x2 wa = *(const u32x2*)(W + fr * 132 + (2 * ks) * 16 + 4 * fq), wb = *(const u32x2*)(W + fr * 132 + (2 * ks + 1) * 16 + 4 * fq);
            const u32x2 qa = *(const u32x2*)(QG + fr * 132 + (2 * ks) * 16 + 4 * fq), qb = *(const u32x2*)(QG + fr * 132 + (2 * ks + 1) * 16 + 4 * fq);
            aw = __builtin_amdgcn_mfma_f32_16x16x32_bf16(__builtin_bit_cast(bf16x8, (u32x4){wa.x, wa.y, wb.x, wb.y}), sf, aw, 0, 0, 0);
            ao = __builtin_amdgcn_mfma_f32_16x16x32_bf16(__builtin_bit_cast(bf16x8, (u32x4){qa.x, qa.y, qb.x, qb.y}), sf, ao, 0, 0, 0);
        }
        f32x4 vn;
#pragma unroll
        for (int jj = 0; jj < 4; ++jj) vn[jj] = bf_1(U[(4 * fq + jj) * 132 + wv * 16 + fr]) - aw[jj];
        const bf16x8 vf = __builtin_bit_cast(bf16x8, (u32x4){cvt_pk_bf16(vn[0], vn[1]), cvt_pk_bf16(vn[2], vn[3]), 0u, 0u});
        { const u32x2 qa = *(const u32x2*)(AQK + fr * 20 + 4 * fq);
          ao = __builtin_amdgcn_mfma_f32_16x16x32_bf16(__builtin_bit_cast(bf16x8, (u32x4){qa.x, qa.y, 0u, 0u}), vf, ao, 0, 0, 0); }
#pragma unroll
        for (int t = 0; t < 8; ++t) { const u32x2 ka = *(const u32x2*)(KDT + (t * 16 + fr) * 20 + 4 * fq);
            Sacc[t] = __builtin_amdgcn_mfma_f32_16x16x32_bf16(__builtin_bit_cast(bf16x8, (u32x4){ka.x, ka.y, 0u, 0u}), vf, Sacc[t] * gl, 0, 0, 0); }
        float* op = go + ((size_t)b * 2048 + c * 16 + 4 * fq) * 512 + h * 128 + wv * 16 + fr;
#pragma unroll
        for (int jj = 0; jj < 4; ++jj) op[jj * 512] = ao[jj];
      }
    }
#undef GREC_LOAD
    float* so = p->out + O_PGS + ((size_t)(e * 8 + b) * 4 + h) * 16384;
#pragma unroll
    for (int t = 0; t < 8; ++t)
#pragma unroll
        for (int jj = 0; jj < 4; ++jj) so[(t * 16 + 4 * fq + jj) * 128 + wv * 16 + fr] = Sacc[t][jj];
}

__device__ __forceinline__ void gdn_scan_tile(PP p, int e, int s, unsigned char* lds) {
    unsigned char* ws = p->ws;
    const float* gq = (const float*)(ws + WS_U + U_GQ); const float* gk = (const float*)(ws + WS_U + U_GK); const float* gv = (const float*)(ws + WS_U + U_GV);
    const float* ga = (const float*)(ws + WS_U + U_GA); const float* gb = (const float*)(ws + WS_U + U_GB); const float* gkq = (const float*)(ws + WS_U + U_GKQ);
    float* go = (float*)(ws + WS_U + U_GO);
    const int bh = s >> 3, cq = s & 7, b = bh >> 2, h = bh & 3, col0 = cq * 16;
    float* qs = (float*)lds; float* ks = qs + 4096; float* vs = ks + 4096; float* sc4 = vs + 512; float* os = sc4 + 128; float* dump = os + 512;
    const int tid = ltid(), w = tid >> 6, lane = tid & 63, c = lane >> 4, pp = lane & 15, mycol = (w & 3) * 4 + c;
    f32x2 S[4];
#pragma unroll
    for (int i = 0; i < 4; ++i) S[i] = (f32x2){0.f, 0.f};
    f32x4 rq[2], rk[2], rv = (f32x4){0.f, 0.f, 0.f, 0.f}; float rsc = 0.f;
#define GDN_LOAD(ck) do { const int t0_ = (ck) * 32; \
        _Pragma("unroll") for (int i = 0; i < 2; ++i) { const int idx = tid + i * 512; const size_t row = (size_t)b * 2048 + t0_ + (idx >> 5); const int c4 = idx & 31; \
            rq[i] = *(const f32x4*)(gq + row * 512 + h * 128 + c4 * 4); rk[i] = *(const f32x4*)(gk + row * 512 + h * 128 + c4 * 4); } \
        if (tid < 128) { const size_t row = (size_t)b * 2048 + t0_ + (tid >> 2); rv = *(const f32x4*)(gv + row * 512 + h * 128 + col0 + (tid & 3) * 4); } \
        else if (tid < 224) { const int j = tid - 128, which = j >> 5; const size_t row = (size_t)b * 2048 + t0_ + (j & 31); \
            rsc = (which == 0 ? ga : (which == 1 ? gb : gkq))[row * 4 + h]; } } while (0)
    GDN_LOAD(0);
    const int oidx = (pp == 0) ? mycol : (512 + (w & 3) * 64 + lane);
    for (int ck = 0; ck < 64; ++ck) {
        __syncthreads();
#pragma unroll
        for (int i = 0; i < 2; ++i) { const int idx = tid + i * 512; *(f32x4*)(qs + idx * 4) = rq[i]; *(f32x4*)(ks + idx * 4) = rk[i]; }
        if (tid < 128) *(f32x4*)(vs + tid * 4) = rv; else if (tid < 224) { const int j = tid - 128; sc4[(j & 31) * 4 + (j >> 5)] = rsc; }
        __syncthreads();
        if (ck < 63) GDN_LOAD(ck + 1);
        if (w < 4) {
            f32x4 k0 = *(const f32x4*)(ks + pp * 8), k1 = *(const f32x4*)(ks + pp * 8 + 4), q0 = *(const f32x4*)(qs + pp * 8), q1 = *(const f32x4*)(qs + pp * 8 + 4), sv = *(const f32x4*)(sc4);
            float v = vs[mycol];
#pragma unroll 4
            for (int tok = 0; tok < 32; ++tok) {
                const int tn = tok < 31 ? tok + 1 : 31;
                const f32x4 nk0 = *(const f32x4*)(ks + tn * 128 + pp * 8), nk1 = *(const f32x4*)(ks + tn * 128 + pp * 8 + 4);
                const f32x4 nq0 = *(const f32x4*)(qs + tn * 128 + pp * 8), nq1 = *(const f32x4*)(qs + tn * 128 + pp * 8 + 4);
                const f32x4 nsv = *(const f32x4*)(sc4 + tn * 4); const float nv = vs[tn * 16 + mycol];
                const float a = sv.x, bt = sv.y, kq = sv.z;
                const f32x2 kv0 = (f32x2){k0.x, k0.y}, kv1 = (f32x2){k0.z, k0.w}, kv2 = (f32x2){k1.x, k1.y}, kv3 = (f32x2){k1.z, k1.w};
                const f32x2 qv0 = (f32x2){q0.x, q0.y}, qv1 = (f32x2){q0.z, q0.w}, qv2 = (f32x2){q1.x, q1.y}, qv3 = (f32x2){q1.z, q1.w};
                const f32x2 kSv = (kv0 * S[0] + kv1 * S[1]) + (kv2 * S[2] + kv3 * S[3]);
                const f32x2 qSv = (qv0 * S[0] + qv1 * S[1]) + (qv2 * S[2] + qv3 * S[3]);
                float kS = kSv.x + kSv.y, qS = qSv.x + qSv.y;
                kS = row16_sum(kS); qS = row16_sum(qS);
                const float vn = bt * (v - a * kS); const float o = a * qS + kq * vn;
                const f32x2 a2 = (f32x2){a, a}, vn2 = (f32x2){vn, vn};
                S[0] = S[0] * a2 + kv0 * vn2; S[1] = S[1] * a2 + kv1 * vn2; S[2] = S[2] * a2 + kv2 * vn2; S[3] = S[3] * a2 + kv3 * vn2;
                os[(pp == 0 ? tok * 16 : 0) + oidx] = o;
                k0 = nk0; k1 = nk1; q0 = nq0; q1 = nq1; sv = nsv; v = nv;
            }
        }
        __syncthreads();
        if (tid < 128) { const size_t row = (size_t)b * 2048 + ck * 32 + (tid >> 2); *(f32x4*)(go + row * 512 + h * 128 + col0 + (tid & 3) * 4) = *(const f32x4*)(os + tid * 4); }
    }
#undef GDN_LOAD
    if (w < 4) {
        float* so = p->out + O_PGS + ((size_t)(e * 8 + b) * 4 + h) * 16384;
#pragma unroll
        for (int i = 0; i < 8; ++i) so[(pp * 8 + i) * 128 + col0 + mycol] = S[i >> 1][i & 1];
    }
}

__device__ __forceinline__ void attn_tile(PP p, int e, int s, unsigned char* lds) {
    unsigned char* ws = p->ws;
    const bf16_t* proj = (const bf16_t*)(ws + WS_P); bf16_t* mix = (bf16_t*)(ws + WS_MIX);
    const int b = s >> 6, qb = (s >> 1) & 31, kv = s & 1, q0 = qb * 64, kstart = q0 - 128;
    bf16_t* Ks = (bf16_t*)lds;
    bf16_t* Vt = Ks + 192 * 72;
    float* bt = (float*)(lds + (192 * 72 + 64 * 200) * 2);
    const int tid = ltid();
    __syncthreads();
#pragma unroll
    for (int i = 0; i < 3; ++i) { const int idx = tid + i * 512, slot = idx >> 3, c8 = idx & 7, pos = kstart + slot;
        u32x4 kk = (u32x4){0u, 0u, 0u, 0u}, vv = kk;
        if (pos >= 0) { const size_t row = (size_t)b * 2048 + pos; kk = *(const u32x4*)(proj + row * EINP + 512 + kv * 64 + c8 * 8); vv = *(const u32x4*)(proj + row * EINP + 640 + kv * 64 + c8 * 8); }
        *(u32x4*)(Ks + slot * 72 + c8 * 8) = kk;
        bf16_t* vp = Vt + (c8 * 8) * 200 + slot;
        vp[0] = (bf16_t)(vv.x & 0xffffu); vp[200] = (bf16_t)(vv.x >> 16); vp[400] = (bf16_t)(vv.y & 0xffffu); vp[600] = (bf16_t)(vv.y >> 16);
        vp[800] = (bf16_t)(vv.z & 0xffffu); vp[1000] = (bf16_t)(vv.z >> 16); vp[1200] = (bf16_t)(vv.w & 0xffffu); vp[1400] = (bf16_t)(vv.w >> 16); }
    for (int idx = tid; idx < 4 * 129; idx += 512) { const int g = idx / 129, d = idx - g * 129; bt[g * 132 + d] = p->in[8][t5_bucket(d) * 8 + kv * 4 + g]; }
    __syncthreads();
    const int w = tid >> 6, lane = tid & 63, g = w >> 1, qhalf = w & 1, hh = kv * 4 + g, fr = lane & 15, fq = lane >> 4;
    const float sink = p->in[21][e * 8 + hh];
    for (int qblk = 0; qblk < 2; ++qblk) {
        const int qs = qhalf * 32 + qblk * 16, kb0 = qs >> 4, qrel = qs + fr;
        const bf16_t* qp = proj + ((size_t)b * 2048 + q0 + qrel) * EINP + hh * 64 + fq * 8;
        const bf16x8 qf0 = *(const bf16x8*)(qp), qf1 = *(const bf16x8*)(qp + 32);
        float sc[10][4];
        float mx = -1e30f;
#pragma unroll
        for (int i = 0; i < 10; ++i) {
            const int kb = kb0 + i;
            if (kb < 12) {
                const bf16_t* kp = Ks + (kb * 16 + fr) * 72 + fq * 8;
                f32x4 a = (f32x4){0.f, 0.f, 0.f, 0.f};
                a = __builtin_amdgcn_mfma_f32_16x16x32_bf16(*(const bf16x8*)(kp), qf0, a, 0, 0, 0);
                a = __builtin_amdgcn_mfma_f32_16x16x32_bf16(*(const bf16x8*)(kp + 32), qf1, a, 0, 0, 0);
#pragma unroll
                for (int jj = 0; jj < 4; ++jj) { const int slot = kb * 16 + 4 * fq + jj, dd = qrel + 128 - slot;
                    const bool valid = (dd >= 0) && (dd <= 128) && (kstart + slot >= 0);
                    const int ddc = dd < 0 ? 0 : (dd > 128 ? 128 : dd);
                    const float v = valid ? a[jj] * 0.125f + bt[g * 132 + ddc] : -1e30f;
                    sc[i][jj] = v; mx = fmaxf(mx, v); }
            } else {
#pragma unroll
                for (int jj = 0; jj < 4; ++jj) sc[i][jj] = -1e30f;
            }
        }
        mx = fmaxf(mx, __shfl_xor(mx, 16)); mx = fmaxf(mx, __shfl_xor(mx, 32));
        const float m = fmaxf(mx, sink);
        float l = 0.f;
#pragma unroll
        for (int i = 0; i < 10; ++i)
#pragma unroll
            for (int jj = 0; jj < 4; ++jj) { const float pe = __expf(sc[i][jj] - m); sc[i][jj] = pe; l += pe; }
        l += __shfl_xor(l, 16); l += __shfl_xor(l, 32);
        l += __expf(sink - m);
        f32x4 o[4];
#pragma unroll
        for (int db = 0; db < 4; ++db) o[db] = (f32x4){0.f, 0.f, 0.f, 0.f};
#pragma unroll
        for (int i2 = 0; i2 < 5; ++i2) {
            const int kbA = kb0 + 2 * i2, kbB = kbA + 1;
            u32x4 pw; pw.x = cvt_pk_bf16(sc[2 * i2][0], sc[2 * i2][1]); pw.y = cvt_pk_bf16(sc[2 * i2][2], sc[2 * i2][3]);
            pw.z = cvt_pk_bf16(sc[2 * i2 + 1][0], sc[2 * i2 + 1][1]); pw.w = cvt_pk_bf16(sc[2 * i2 + 1][2], sc[2 * i2 + 1][3]);
            const bf16x8 pf = __builtin_bit_cast(bf16x8, pw);
            const int slotA = (kbA < 12 ? kbA : 11) * 16 + 4 * fq, slotB = (kbB < 12 ? kbB : 11) * 16 + 4 * fq;
#pragma unroll
            for (int db = 0; db < 4; ++db) {
                const bf16_t* vp = Vt + (db * 16 + fr) * 200;
                const u32x2 va = *(const u32x2*)(vp + slotA), vb = *(const u32x2*)(vp + slotB);
                const bf16x8 vf = __builtin_bit_cast(bf16x8, (u32x4){va.x, va.y, vb.x, vb.y});
                o[db] = __builtin_amdgcn_mfma_f32_16x16x32_bf16(vf, pf, o[db], 0, 0, 0);
            }
        }
        const float inv = 1.f / l;
        bf16_t* mp = mix + ((size_t)b * 2048 + q0 + qrel) * 1024 + hh * 64 + 4 * fq;
#pragma unroll
        for (int db = 0; db < 4; ++db) { u32x2 wv; wv.x = cvt_pk_bf16(o[db].x * inv, o[db].y * inv); wv.y = cvt_pk_bf16(o[db].z * inv, o[db].w * inv); *(u32x2*)(mp + db * 16) = wv; }
    }
}

__device__ __forceinline__ void gdn_dec_tile(PP p, int e, int s, unsigned char* lds) {
    unsigned char* ws = p->ws;
    const float* gq = (const float*)(ws + WS_U + U_GQ); const float* gk = (const float*)(ws + WS_U + U_GK); const float* gv = (const float*)(ws + WS_U + U_GV);
    const float* ga = (const float*)(ws + WS_U + U_GA); const float* gb = (const float*)(ws + WS_U + U_GB); const float* gkq = (const float*)(ws + WS_U + U_GKQ);
    float* go = (float*)(ws + WS_U + U_GO);
    const int b = s >> 2, h = s & 3, tid = ltid(), ee = tid & 127, part = tid >> 7; const size_t row = (size_t)TP + b;
    float* red = (float*)lds; float* ksh = red + 512; float* qsh = ksh + 128;
    __syncthreads();
    if (tid < 128) ksh[tid] = gk[row * 512 + h * 128 + tid]; else if (tid < 256) qsh[tid - 128] = gq[row * 512 + h * 128 + tid - 128];
    const float a = ga[row * 4 + h], bt = gb[row * 4 + h], kq = gkq[row * 4 + h], v = gv[row * 512 + h * 128 + ee];
    const float* S0 = p->in[5] + ((size_t)(e * 128 + b) * 4 + h) * 16384;
    float S[32];
#pragma unroll
    for (int i = 0; i < 32; ++i) S[i] = S0[(part * 32 + i) * 128 + ee];
    __syncthreads();
    float ksum = 0.f;
#pragma unroll
    for (int i = 0; i < 32; ++i) ksum += ksh[part * 32 + i] * S[i];
    red[part * 128 + ee] = ksum;
    __syncthreads();
    const float kS = (red[ee] + red[128 + ee]) + (red[256 + ee] + red[384 + ee]);
    const float vn = bt * (v - a * kS);
    float* so = p->out + O_SGS + ((size_t)(e * 128 + b) * 4 + h) * 16384;
    float qsum = 0.f;
#pragma unroll
    for (int i = 0; i < 32; ++i) { S[i] = a * S[i] + ksh[part * 32 + i] * vn; qsum += qsh[part * 32 + i] * S[i]; so[(part * 32 + i) * 128 + ee] = S[i]; }
    __syncthreads();
    red[part * 128 + ee] = qsum;
    __syncthreads();
    if (part == 0) go[row * 512 + h * 128 + ee] = (red[ee] + red[128 + ee]) + (red[256 + ee] + red[384 + ee]);
    (void)kq;
}

__device__ __forceinline__ void attn_dec_tile(PP p, int e, int s, unsigned char* lds) {
    unsigned char* ws = p->ws;
    const bf16_t* proj = (const bf16_t*)(ws + WS_P); bf16_t* mix = (bf16_t*)(ws + WS_MIX);
    const int b = s, tid = ltid(), hh = tid >> 6, lane = tid & 63, kv = hh >> 2; const size_t row = (size_t)TP + b;
    float* qsh = (float*)lds + hh * 256; float* psh = qsh + 64;
    __syncthreads();
    qsh[lane] = bf_1(proj[row * EINP + hh * 64 + lane]) * 0.125f;
    asm volatile("s_waitcnt lgkmcnt(0)" ::: "memory");
    const float* Kc = p->in[2] + (size_t)(e * 128 + b) * 16384; const float* Vc = p->in[3] + (size_t)(e * 128 + b) * 16384;
    float s0 = 0.f, s1 = 0.f, s2 = 0.f;
    { const float* k0p = Kc + (lane * 2 + kv) * 64; const float* k1p = Kc + ((lane + 64) * 2 + kv) * 64; const bf16_t* k2p = proj + row * EINP + 512 + kv * 64;
#pragma unroll 8
      for (int c4 = 0; c4 < 16; ++c4) { const f32x4 qv = *(const f32x4*)(qsh + c4 * 4); s0 += dot4(qv, *(const f32x4*)(k0p + c4 * 4)); s1 += dot4(qv, *(const f32x4*)(k1p + c4 * 4)); s2 += dot4(qv, bf4(*(const u32x2*)(k2p + c4 * 4))); } }
    s0 += p->in[8][t5_bucket(128 - lane) * 8 + hh]; s1 += p->in[8][t5_bucket(64 - lane) * 8 + hh]; s2 += p->in[8][hh];
    const float sink = p->in[21][e * 8 + hh];
    const float m = fmaxf(wave_max(fmaxf(fmaxf(s0, s1), s2)), sink);
    const float p0 = __expf(s0 - m), p1 = __expf(s1 - m), p2 = __expf(s2 - m);
    const float den = wave_sum(p0 + p1) + p2 + __expf(sink - m);
    psh[lane] = p0; psh[64 + lane] = p1; if (lane == 0) psh[128] = p2;
    asm volatile("s_waitcnt lgkmcnt(0)" ::: "memory");
    float o = 0.f;
    float o2 = 0.f, o3 = 0.f, o4 = 0.f;
#pragma unroll 1
    for (int j0 = 0; j0 < 128; j0 += 32) {
        float vv[32];
#pragma unroll
        for (int u = 0; u < 32; ++u) vv[u] = Vc[((j0 + u) * 2 + kv) * 64 + lane];
#pragma unroll
        for (int u = 0; u < 32; u += 4) { o += psh[j0 + u] * vv[u]; o2 += psh[j0 + u + 1] * vv[u + 1]; o3 += psh[j0 + u + 2] * vv[u + 2]; o4 += psh[j0 + u + 3] * vv[u + 3]; }
    }
    o = (o + o2) + (o3 + o4);
    o += psh[128] * bf_1(proj[row * EINP + 640 + kv * 64 + lane]);
    o /= den;
    const float on = __shfl_down(o, 1);
    if ((lane & 1) == 0) *(unsigned*)(mix + row * 1024 + hh * 64 + lane) = cvt_pk_bf16(o, on);
}

__device__ __forceinline__ void even_post(PP p, int e, int gw, int NGW, int lane) {
    unsigned char* ws = p->ws;
    const bf16_t* proj = (const bf16_t*)(ws + WS_P); const float* go = (const float*)(ws + WS_U + U_GO); bf16_t* mix = (bf16_t*)(ws + WS_MIX);
    const float* gn = p->in[25] + e * 128;
    const int c = lane * 2;
    const f32x2 g = *(const f32x2*)(gn + c);
    for (int it0 = gw; it0 < T * 4; it0 += 4 * NGW) {
        f32x2 o[4]; unsigned zu[4]; bool ok[4];
#pragma unroll
        for (int u = 0; u < 4; ++u) { const int it = it0 + u * NGW; ok[u] = it < T * 4; const int itc = ok[u] ? it : it0; const int r = itc >> 2, h = itc & 3;
            o[u] = *(const f32x2*)(go + (size_t)r * 512 + h * 128 + c); zu[u] = *(const unsigned*)(proj + (size_t)r * EINP + 2304 + h * 128 + c); }
#pragma unroll
        for (int u = 0; u < 4; ++u) { const int it = it0 + u * NGW; const int r = it >> 2, h = it & 3;
            const float rs = rsqrtf(wave_sum(o[u].x * o[u].x + o[u].y * o[u].y) * (1.f / 128.f) + EPS);
            const f32x2 z = (f32x2){bf_lo(zu[u]), bf_hi(zu[u])};
            if (ok[u]) *(unsigned*)(mix + (size_t)r * 1024 + 512 + h * 128 + c) = cvt_pk_bf16(o[u].x * rs * g.x * silu_f(z.x), o[u].y * rs * g.y * silu_f(z.y)); }
    }
}

__device__ __forceinline__ void odd_prep(PP p, int e, long gt, long GT) {
    unsigned char* ws = p->ws;
    const bf16_t* proj = (const bf16_t*)(ws + WS_P); const float* gate = (const float*)(ws + WS_GATE);
    float* xbc = (float*)(ws + WS_U + U_XBC); float* dtb = (float*)(ws + WS_U + U_DT); float* dab = (float*)(ws + WS_U + U_DA);
    const float* cw = p->in[28] + (size_t)e * 4 * 3072; const float* cb = p->in[29] + (size_t)e * 3072; const float* hist = p->in[6] + (size_t)e * 128 * 3 * 3072;
    for (long i = gt; i < 393216 + 49152; i += GT) {
        const bool smp = i >= 393216;
        int b, t0, nt, c8;
        if (!smp) { c8 = (int)(i % 384); const int q = (int)(i / 384); t0 = (q & 127) * 16; b = q >> 7; nt = 16; } else { const int j = (int)(i - 393216); c8 = j % 384; b = j / 384; t0 = 0; nt = 1; }
        const int ch = c8 * 8;
        f32x4 w[4][2], prev[3][2];
#pragma unroll
        for (int k = 0; k < 4; ++k) { w[k][0] = *(const f32x4*)(cw + k * 3072 + ch); w[k][1] = *(const f32x4*)(cw + k * 3072 + ch + 4); }
        const f32x4 b0 = *(const f32x4*)(cb + ch), b1 = *(const f32x4*)(cb + ch + 4);
#pragma unroll
        for (int k = 0; k < 3; ++k) {
            if (smp) { prev[k][0] = *(const f32x4*)(hist + (size_t)(b * 3 + k) * 3072 + ch); prev[k][1] = *(const f32x4*)(hist + (size_t)(b * 3 + k) * 3072 + ch + 4); }
            else { const int tt = t0 - 3 + k;
                if (tt >= 0) { const u32x4 u = *(const u32x4*)(proj + ((size_t)b * 2048 + tt) * OINP + 2048 + ch); prev[k][0] = bf4((u32x2){u.x, u.y}); prev[k][1] = bf4((u32x2){u.z, u.w}); }
                else { prev[k][0] = (f32x4){0.f, 0.f, 0.f, 0.f}; prev[k][1] = prev[k][0]; } }
        }
#pragma unroll 8
        for (int t = 0; t < nt; ++t) {
            const size_t r = smp ? (size_t)TP + b : (size_t)b * 2048 + t0 + t;
            const u32x4 u = *(const u32x4*)(proj + r * OINP + 2048 + ch);
            const f32x4 c0 = bf4((u32x2){u.x, u.y}), c1 = bf4((u32x2){u.z, u.w});
            const f32x4 a0 = b0 + (prev[0][0] * w[0][0] + prev[1][0] * w[1][0]) + (prev[2][0] * w[2][0] + c0 * w[3][0]);
            const f32x4 a1 = b1 + (prev[0][1] * w[0][1] + prev[1][1] * w[1][1]) + (prev[2][1] * w[2][1] + c1 * w[3][1]);
            prev[0][0] = prev[1][0]; prev[0][1] = prev[1][1]; prev[1][0] = prev[2][0]; prev[1][1] = prev[2][1]; prev[2][0] = c0; prev[2][1] = c1;
            const f32x4 s0 = (f32x4){silu_f(a0.x), silu_f(a0.y), silu_f(a0.z), silu_f(a0.w)}, s1 = (f32x4){silu_f(a1.x), silu_f(a1.y), silu_f(a1.z), silu_f(a1.w)};
            if (smp) { *(f32x4*)(xbc + r * 3072 + ch) = s0; *(f32x4*)(xbc + r * 3072 + ch + 4) = s1; }
            else { u32x4 w8; w8.x = cvt_pk_bf16(s0.x, s0.y); w8.y = cvt_pk_bf16(s0.z, s0.w); w8.z = cvt_pk_bf16(s1.x, s1.y); w8.w = cvt_pk_bf16(s1.z, s1.w);
                   *(u32x4*)((bf16_t*)(ws + WS_U + U_XBF) + r * 3072 + ch) = w8; }
        }
    }
    for (long i = gt; i < (long)T * 32; i += GT) { const int r = (int)(i >> 5), hh = (int)(i & 31);
        const float dt = softplus_f(gate[(size_t)r * 32 + hh] + p->in[30][e * 32 + hh]); const float A = -__expf(p->in[31][e * 32 + hh]);
        dtb[i] = dt; dab[i] = __expf(dt * A); }
    float* out = p->out;
    for (long i = gt; i < 73728; i += GT) { const int ch = (int)(i % 3072), j = (int)((i / 3072) % 3), b = (int)(i / 9216);
        out[O_PSC + (size_t)e * 73728 + i] = bf_1(proj[((size_t)b * 2048 + 2045 + j) * OINP + 2048 + ch]); }
    for (long i = gt; i < 1179648; i += GT) { const int ch = (int)(i % 3072), j = (int)((i / 3072) % 3), b = (int)(i / 9216);
        out[O_SSC + (size_t)e * 1179648 + i] = j < 2 ? hist[(size_t)(b * 3 + j + 1) * 3072 + ch] : bf_1(proj[(size_t)(TP + b) * OINP + 2048 + ch]); }
}

__device__ __forceinline__ void ssd_scan_tile(PP p, int e, int s, unsigned char* lds) {
    unsigned char* ws = p->ws;
    float* xbc = (float*)(ws + WS_U + U_XBC); const float* dtb = (const float*)(ws + WS_U + U_DT); const float* dab = (const float*)(ws + WS_U + U_DA);
    const int b = s >> 5, hh = s & 31, g = hh >> 3;
    float* Bs = (float*)lds; float* Cs = Bs + 4096; float* xs = Cs + 4096; float* ys = xs + 2048; float* dts = ys + 2048;
    const int tid = ltid(), w = tid >> 6, lane = tid & 63, r_ = lane >> 4, j = lane & 15, p0 = w * 8 + r_ * 2, n0 = j * 8;
    const float Dh = p->in[32][e * 32 + hh];
    f32x2 S0[4], S1[4];
#pragma unroll
    for (int i = 0; i < 4; ++i) { S0[i] = (f32x2){0.f, 0.f}; S1[i] = (f32x2){0.f, 0.f}; }
    f32x4 rB[2], rC[2], rx; float rd = 0.f;
#define SSD_LOAD(ck) do { const int t0_ = (ck) * 32; \
        _Pragma("unroll") for (int i = 0; i < 2; ++i) { const int idx = tid + i * 512; const size_t row = (size_t)b * 2048 + t0_ + (idx >> 5); const int c4 = idx & 31; \
            rB[i] = *(const f32x4*)(xbc + row * 3072 + 2048 + g * 128 + c4 * 4); rC[i] = *(const f32x4*)(xbc + row * 3072 + 2560 + g * 128 + c4 * 4); } \
        { const size_t row = (size_t)b * 2048 + t0_ + (tid >> 4); rx = *(const f32x4*)(xbc + row * 3072 + hh * 64 + (tid & 15) * 4); } \
        if (tid < 64) { const size_t row = (size_t)b * 2048 + t0_ + (tid & 31); rd = ((tid >> 5) ? dab : dtb)[row * 32 + hh]; } } while (0)
    SSD_LOAD(0);
    for (int ck = 0; ck < 64; ++ck) {
        __syncthreads();
#pragma unroll
        for (int i = 0; i < 2; ++i) { const int idx = tid + i * 512; *(f32x4*)(Bs + idx * 4) = rB[i]; *(f32x4*)(Cs + idx * 4) = rC[i]; }
        *(f32x4*)(xs + tid * 4) = rx; if (tid < 64) dts[tid] = rd;
        __syncthreads();
        if (ck < 63) SSD_LOAD(ck + 1);
#pragma unroll 2
        for (int tok = 0; tok < 32; ++tok) {
            const float dt = dts[tok], dA = dts[32 + tok];
            const f32x2 xv = *(const f32x2*)(xs + tok * 64 + p0);
            const f32x4 B0 = *(const f32x4*)(Bs + tok * 128 + n0), B1 = *(const f32x4*)(Bs + tok * 128 + n0 + 4);
            const f32x4 C0 = *(const f32x4*)(Cs + tok * 128 + n0), C1 = *(const f32x4*)(Cs + tok * 128 + n0 + 4);
            const f32x2 xd0 = (f32x2){dt * xv.x, dt * xv.x}, xd1 = (f32x2){dt * xv.y, dt * xv.y}, dA2 = (f32x2){dA, dA};
            const f32x2 Bv[4] = {(f32x2){B0.x, B0.y}, (f32x2){B0.z, B0.w}, (f32x2){B1.x, B1.y}, (f32x2){B1.z, B1.w}};
            const f32x2 Cv[4] = {(f32x2){C0.x, C0.y}, (f32x2){C0.z, C0.w}, (f32x2){C1.x, C1.y}, (f32x2){C1.z, C1.w}};
            f32x2 y0v = (f32x2){0.f, 0.f}, y1v = (f32x2){0.f, 0.f};
#pragma unroll
            for (int i = 0; i < 4; ++i) { S0[i] = S0[i] * dA2 + xd0 * Bv[i]; S1[i] = S1[i] * dA2 + xd1 * Bv[i]; y0v += Cv[i] * S0[i]; y1v += Cv[i] * S1[i]; }
            float y0 = y0v.x + y0v.y, y1 = y1v.x + y1v.y;
            y0 = row16_sum(y0); y1 = row16_sum(y1);
            if (j == 0) *(f32x2*)(ys + tok * 64 + p0) = (f32x2){y0 + Dh * xv.x, y1 + Dh * xv.y};
        }
        __syncthreads();
        { const size_t row = (size_t)b * 2048 + ck * 32 + (tid >> 4); *(f32x4*)(xbc + row * 3072 + hh * 64 + (tid & 15) * 4) = *(const f32x4*)(ys + tid * 4); }
    }
#undef SSD_LOAD
    float* so = p->out + O_PSS + ((size_t)(e * 8 + b) * 32 + hh) * 8192;
    *(f32x4*)(so + p0 * 128 + n0) = (f32x4){S0[0].x, S0[0].y, S0[1].x, S0[1].y}; *(f32x4*)(so + p0 * 128 + n0 + 4) = (f32x4){S0[2].x, S0[2].y, S0[3].x, S0[3].y};
    *(f32x4*)(so + (p0 + 1) * 128 + n0) = (f32x4){S1[0].x, S1[0].y, S1[1].x, S1[1].y}; *(f32x4*)(so + (p0 + 1) * 128 + n0 + 4) = (f32x4){S1[2].x, S1[2].y, S1[3].x, S1[3].y};
}

__device__ __forceinline__ void ssd_chunk_tile(PP p, int e, int s, unsigned char* lds) {
    unsigned char* ws = p->ws;
    float* xbc = (float*)(ws + WS_U + U_XBC); const float* dtb = (const float*)(ws + WS_U + U_DT);
    const int b = s >> 5, hh = s & 31, g = hh >> 3;
    bf16_t* Cb = (bf16_t*)lds; bf16_t* Bb = Cb + 64 * 136; bf16_t* BT = Bb + 64 * 136; bf16_t* XT = BT + 128 * 72; bf16_t* XwT = XT + 64 * 72; bf16_t* Mb = XwT + 64 * 72; bf16_t* Sb = Mb + 64 * 72;
    float* fa = (float*)(lds + 98304);
    const int tid = ltid(), wv = tid >> 6, lane = tid & 63, fr = lane & 15, fq = lane >> 4;
    const float Ah = -__expf(p->in[31][e * 32 + hh]), Dh = p->in[32][e * 32 + hh];
    __syncthreads();
    for (int i = tid; i < 64 * 136 / 2; i += 512) ((unsigned*)Sb)[i] = 0u;
    f32x4 Sacc[4];
#pragma unroll
    for (int k = 0; k < 4; ++k) Sacc[k] = (f32x4){0.f, 0.f, 0.f, 0.f};
    const bf16_t* xbf = (const bf16_t*)(ws + WS_U + U_XBF); bf16_t* ybf = (bf16_t*)(ws + WS_U + U_YBF);
    u32x4 rB[2], rC[2], rx; float rdt = 0.f;
#define SSDC_LOAD(ck) do { const size_t r0_ = (size_t)b * 2048 + (ck) * 64; \
        _Pragma("unroll") for (int i = 0; i < 2; ++i) { const int idx = tid + i * 512; const size_t row = r0_ + (idx >> 4); const int c8 = idx & 15; \
            rB[i] = *(const u32x4*)(xbf + row * 3072 + 2048 + g * 128 + c8 * 8); rC[i] = *(const u32x4*)(xbf + row * 3072 + 2560 + g * 128 + c8 * 8); } \
        { const size_t row = r0_ + (tid >> 3); rx = *(const u32x4*)(xbf + row * 3072 + hh * 64 + (tid & 7) * 8); } \
        if (tid < 64) rdt = dtb[(r0_ + tid) * 32 + hh]; } while (0)
    SSDC_LOAD(0);
    const int pi_s = wv >> 1;
    for (int ck = 0; ck < 32; ++ck) {
        __syncthreads();
#pragma unroll
        for (int i = 0; i < 2; ++i) { const int idx = tid + i * 512, tok = idx >> 4, n8 = (idx & 15) * 8;
            *(u32x4*)(Bb + tok * 136 + n8) = rB[i]; *(u32x4*)(Cb + tok * 136 + n8) = rC[i];
            BT[(n8 + 0) * 72 + tok] = (bf16_t)(rB[i].x & 0xffffu); BT[(n8 + 1) * 72 + tok] = (bf16_t)(rB[i].x >> 16); BT[(n8 + 2) * 72 + tok] = (bf16_t)(rB[i].y & 0xffffu); BT[(n8 + 3) * 72 + tok] = (bf16_t)(rB[i].y >> 16);
            BT[(n8 + 4) * 72 + tok] = (bf16_t)(rB[i].z & 0xffffu); BT[(n8 + 5) * 72 + tok] = (bf16_t)(rB[i].z >> 16); BT[(n8 + 6) * 72 + tok] = (bf16_t)(rB[i].w & 0xffffu); BT[(n8 + 7) * 72 + tok] = (bf16_t)(rB[i].w >> 16); }
        { const int tok = tid >> 3, p8 = (tid & 7) * 8;
            XT[(p8 + 0) * 72 + tok] = (bf16_t)(rx.x & 0xffffu); XT[(p8 + 1) * 72 + tok] = (bf16_t)(rx.x >> 16); XT[(p8 + 2) * 72 + tok] = (bf16_t)(rx.y & 0xffffu); XT[(p8 + 3) * 72 + tok] = (bf16_t)(rx.y >> 16);
            XT[(p8 + 4) * 72 + tok] = (bf16_t)(rx.z & 0xffffu); XT[(p8 + 5) * 72 + tok] = (bf16_t)(rx.z >> 16); XT[(p8 + 6) * 72 + tok] = (bf16_t)(rx.w & 0xffffu); XT[(p8 + 7) * 72 + tok] = (bf16_t)(rx.w >> 16); }
        if (tid < 64) { fa[tid] = rdt * Ah; fa[256 + tid] = rdt; }
        __syncthreads();
        f32x4 gacc[2];
#pragma unroll
        for (int k = 0; k < 2; ++k) { const int tI = wv * 2 + k, li = tI >> 2, si = tI & 3;
            gacc[k] = (f32x4){0.f, 0.f, 0.f, 0.f};
            if (si <= li) {
#pragma unroll
                for (int ks = 0; ks < 4; ++ks) gacc[k] = __builtin_amdgcn_mfma_f32_16x16x32_bf16(*(const bf16x8*)(Cb + (li * 16 + fr) * 136 + ks * 32 + fq * 8), *(const bf16x8*)(Bb + (si * 16 + fr) * 136 + ks * 32 + fq * 8), gacc[k], 0, 0, 0);
            } }
        if (wv == 0) {
            float a = fa[lane];
#pragma unroll
            for (int off = 1; off < 64; off <<= 1) { const float t = __shfl_up(a, off); if (lane >= off) a += t; }
            const float last = __shfl(a, 63);
            fa[64 + lane] = a; fa[128 + lane] = __expf(last - a) * fa[256 + lane]; fa[192 + lane] = __expf(a);
            if (lane == 0) fa[320] = __expf(last);
        }
        __syncthreads();
#pragma unroll
        for (int k = 0; k < 2; ++k) { const int tI = wv * 2 + k, li = tI >> 2, si = tI & 3, sc = si * 16 + fr;
            const float as_ = fa[64 + sc], ds_ = fa[256 + sc];
#pragma unroll
            for (int jj = 0; jj < 4; ++jj) { const int l = li * 16 + 4 * fq + jj;
                const float v = (sc <= l) ? gacc[k][jj] * __expf(fa[64 + l] - as_) * ds_ : 0.f;
                Mb[l * 72 + sc] = bf16_of(v); } }
        { const int tok = tid >> 3, p8 = (tid & 7) * 8; const float ww = fa[128 + tok];
            const unsigned w0 = cvt_pk_bf16(bf_lo(rx.x) * ww, bf_hi(rx.x) * ww), w1 = cvt_pk_bf16(bf_lo(rx.y) * ww, bf_hi(rx.y) * ww), w2 = cvt_pk_bf16(bf_lo(rx.z) * ww, bf_hi(rx.z) * ww), w3 = cvt_pk_bf16(bf_lo(rx.w) * ww, bf_hi(rx.w) * ww);
            XwT[(p8 + 0) * 72 + tok] = (bf16_t)(w0 & 0xffffu); XwT[(p8 + 1) * 72 + tok] = (bf16_t)(w0 >> 16); XwT[(p8 + 2) * 72 + tok] = (bf16_t)(w1 & 0xffffu); XwT[(p8 + 3) * 72 + tok] = (bf16_t)(w1 >> 16);
            XwT[(p8 + 4) * 72 + tok] = (bf16_t)(w2 & 0xffffu); XwT[(p8 + 5) * 72 + tok] = (bf16_t)(w2 >> 16); XwT[(p8 + 6) * 72 + tok] = (bf16_t)(w3 & 0xffffu); XwT[(p8 + 7) * 72 + tok] = (bf16_t)(w3 >> 16); }
        if (ck < 31) SSDC_LOAD(ck + 1);
        __syncthreads();
#pragma unroll
        for (int k = 0; k < 2; ++k) { const int tI = wv * 2 + k, pi = tI >> 2, lj = tI & 3, l = lj * 16 + fr;
            f32x4 acc = (f32x4){0.f, 0.f, 0.f, 0.f};
#pragma unroll
            for (int ks = 0; ks < 4; ++ks) acc = __builtin_amdgcn_mfma_f32_16x16x32_bf16(*(const bf16x8*)(Sb + (pi * 16 + fr) * 136 + ks * 32 + fq * 8), *(const bf16x8*)(Cb + (lj * 16 + fr) * 136 + ks * 32 + fq * 8), acc, 0, 0, 0);
            acc = acc * fa[192 + l];
#pragma unroll
            for (int ks = 0; ks < 2; ++ks) acc = __builtin_amdgcn_mfma_f32_16x16x32_bf16(*(const bf16x8*)(XT + (pi * 16 + fr) * 72 + ks * 32 + fq * 8), *(const bf16x8*)(Mb + (lj * 16 + fr) * 72 + ks * 32 + fq * 8), acc, 0, 0, 0);
#pragma unroll
            for (int jj = 0; jj < 4; ++jj) acc[jj] += Dh * bf_1(XT[(pi * 16 + 4 * fq + jj) * 72 + l]);
            { u32x2 yw; yw.x = cvt_pk_bf16(acc[0], acc[1]); yw.y = cvt_pk_bf16(acc[2], acc[3]); *(u32x2*)(ybf + ((size_t)b * 2048 + ck * 64 + l) * 2048 + hh * 64 + pi * 16 + 4 * fq) = yw; } }
        { const float cd = fa[320];
#pragma unroll
          for (int k = 0; k < 4; ++k) { const int nj = (wv & 1) * 4 + k;
            Sacc[k] = Sacc[k] * cd;
#pragma unroll
            for (int ks = 0; ks < 2; ++ks) Sacc[k] = __builtin_amdgcn_mfma_f32_16x16x32_bf16(*(const bf16x8*)(XwT + (pi_s * 16 + fr) * 72 + ks * 32 + fq * 8), *(const bf16x8*)(BT + (nj * 16 + fr) * 72 + ks * 32 + fq * 8), Sacc[k], 0, 0, 0); } }
        __syncthreads();
#pragma unroll
        for (int k = 0; k < 4; ++k) { const int nj = (wv & 1) * 4 + k;
#pragma unroll
            for (int jj = 0; jj < 4; ++jj) Sb[(pi_s * 16 + 4 * fq + jj) * 136 + nj * 16 + fr] = bf16_of(Sacc[k][jj]); }
    }
#undef SSDC_LOAD
    float* so = p->out + O_PSS + ((size_t)(e * 8 + b) * 32 + hh) * 8192;
#pragma unroll
    for (int k = 0; k < 4; ++k) { const int nj = (wv & 1) * 4 + k;
#pragma unroll
        for (int jj = 0; jj < 4; ++jj) so[(pi_s * 16 + 4 * fq + jj) * 128 + nj * 16 + fr] = Sacc[k][jj]; }
}

__device__ __forceinline__ void ssd_dec_tile(PP p, int e, int s) {
    unsigned char* ws = p->ws;
    float* xbc = (float*)(ws + WS_U + U_XBC); const float* dtb = (const float*)(ws + WS_U + U_DT); const float* dab = (const float*)(ws + WS_U + U_DA);
    const int b = s >> 2, g = s & 3; const size_t row = (size_t)TP + b;
    const int tid = ltid(), w = tid >> 6, lane = tid & 63, r_ = lane >> 4, j = lane & 15, p0 = w * 8 + r_ * 2, n0 = j * 8;
    const f32x4 B0 = *(const f32x4*)(xbc + row * 3072 + 2048 + g * 128 + n0), B1 = *(const f32x4*)(xbc + row * 3072 + 2048 + g * 128 + n0 + 4);
    const f32x4 C0 = *(const f32x4*)(xbc + row * 3072 + 2560 + g * 128 + n0), C1 = *(const f32x4*)(xbc + row * 3072 + 2560 + g * 128 + n0 + 4);
    for (int k = 0; k < 8; ++k) {
        const int hh = g * 8 + k;
        const float dt = dtb[row * 32 + hh], dA = dab[row * 32 + hh], Dh = p->in[32][e * 32 + hh];
        const f32x2 xv = *(const f32x2*)(xbc + row * 3072 + hh * 64 + p0);
        const size_t so = ((size_t)(e * 128 + b) * 32 + hh) * 8192 + (size_t)p0 * 128 + n0;
        const float* sp = p->in[7] + so; float* op = p->out + O_SSS + so;
        f32x4 a0 = *(const f32x4*)(sp), a1 = *(const f32x4*)(sp + 4), c0 = *(const f32x4*)(sp + 128), c1 = *(const f32x4*)(sp + 132);
        const float xd0 = dt * xv.x, xd1 = dt * xv.y;
        a0 = a0 * dA + B0 * xd0; a1 = a1 * dA + B1 * xd0; c0 = c0 * dA + B0 * xd1; c1 = c1 * dA + B1 * xd1;
        *(f32x4*)(op) = a0; *(f32x4*)(op + 4) = a1; *(f32x4*)(op + 128) = c0; *(f32x4*)(op + 132) = c1;
        float y0 = dot4(C0, a0) + dot4(C1, a1), y1 = dot4(C0, c0) + dot4(C1, c1);
        y0 = row16_sum(y0); y1 = row16_sum(y1);
        if (j == 0) *(f32x2*)(xbc + row * 3072 + hh * 64 + p0) = (f32x2){y0 + Dh * xv.x, y1 + Dh * xv.y};
    }
}

__device__ __forceinline__ void odd_post(PP p, int e, int gw, int NGW, int lane) {
    unsigned char* ws = p->ws;
    const bf16_t* proj = (const bf16_t*)(ws + WS_P); const float* xbc = (const float*)(ws + WS_U + U_XBC); bf16_t* mix = (bf16_t*)(ws + WS_MIX);
    const bf16_t* ybf = (const bf16_t*)(ws + WS_U + U_YBF);
    const float* gn = p->in[33] + (size_t)e * 2048;
    for (int it0 = gw; it0 < TP * 4; it0 += 2 * NGW) {
        u32x4 yu[2], zu[2]; bool ok[2];
#pragma unroll
        for (int u = 0; u < 2; ++u) { const int it = it0 + u * NGW; ok[u] = it < TP * 4; const int itc = ok[u] ? it : it0; const int r = itc >> 2, ch = (itc & 3) * 512 + lane * 8;
            yu[u] = *(const u32x4*)(ybf + (size_t)r * 2048 + ch); zu[u] = *(const u32x4*)(proj + (size_t)r * OINP + ch); }
#pragma unroll
        for (int u = 0; u < 2; ++u) { const int it = it0 + u * NGW; const int r = it >> 2, ch = (it & 3) * 512 + lane * 8;
            f32x4 y0 = bf4((u32x2){yu[u].x, yu[u].y}), y1 = bf4((u32x2){yu[u].z, yu[u].w});
            const f32x4 z0 = bf4((u32x2){zu[u].x, zu[u].y}), z1 = bf4((u32x2){zu[u].z, zu[u].w});
            y0 = y0 * (f32x4){silu_f(z0.x), silu_f(z0.y), silu_f(z0.z), silu_f(z0.w)}; y1 = y1 * (f32x4){silu_f(z1.x), silu_f(z1.y), silu_f(z1.z), silu_f(z1.w)};
            const float rs = rsqrtf(wave_sum(dot4(y0, y0) + dot4(y1, y1)) * (1.f / 512.f) + EPS);
            if (ok[u]) { const f32x4 g0 = *(const f32x4*)(gn + ch), g1 = *(const f32x4*)(gn + ch + 4);
                y0 = y0 * g0 * rs; y1 = y1 * g1 * rs;
                u32x4 w; w.x = cvt_pk_bf16(y0.x, y0.y); w.y = cvt_pk_bf16(y0.z, y0.w); w.z = cvt_pk_bf16(y1.x, y1.y); w.w = cvt_pk_bf16(y1.z, y1.w);
                *(u32x4*)(mix + (size_t)r * 2048 + ch) = w; } }
    }
    for (int it = TP * 4 + gw; it < T * 4; it += NGW) {
        const int r = it >> 2, g = it & 3, ch = g * 512 + lane * 8;
        f32x4 y0 = *(const f32x4*)(xbc + (size_t)r * 3072 + ch), y1 = *(const f32x4*)(xbc + (size_t)r * 3072 + ch + 4);
        const u32x4 zu = *(const u32x4*)(proj + (size_t)r * OINP + ch); const f32x4 z0 = bf4((u32x2){zu.x, zu.y}), z1 = bf4((u32x2){zu.z, zu.w});
        y0 = y0 * (f32x4){silu_f(z0.x), silu_f(z0.y), silu_f(z0.z), silu_f(z0.w)}; y1 = y1 * (f32x4){silu_f(z1.x), silu_f(z1.y), silu_f(z1.z), silu_f(z1.w)};
        const float rs = rsqrtf(wave_sum(dot4(y0, y0) + dot4(y1, y1)) * (1.f / 512.f) + EPS);
        const f32x4 g0 = *(const f32x4*)(gn + ch), g1 = *(const f32x4*)(gn + ch + 4);
        y0 = y0 * g0 * rs; y1 = y1 * g1 * rs;
        u32x4 w; w.x = cvt_pk_bf16(y0.x, y0.y); w.y = cvt_pk_bf16(y0.z, y0.w); w.z = cvt_pk_bf16(y1.x, y1.y); w.w = cvt_pk_bf16(y1.z, y1.w);
        *(u32x4*)(mix + (size_t)r * 2048 + ch) = w;
    }
}

#define XB_TMO      128
#define XB_XCNT(j)  (256  + 64 * (j))
#define XB_XSUB(j)  (1280 + 64 * (j))
#define XB_XGEN(j)  (2304 + 64 * (j))
#define XB_TOP      3328
#define XB_TOPGEN   3392
#define XCD_BAR_WORDS 3456
#define XB_SPIN_CAP (1u << 18)
__device__ __forceinline__ unsigned xb_ld(unsigned* p)              { return __hip_atomic_load(p, __ATOMIC_RELAXED, __HIP_MEMORY_SCOPE_AGENT); }
__device__ __forceinline__ unsigned xb_add(unsigned* p, unsigned v) { return __hip_atomic_fetch_add(p, v, __ATOMIC_RELAXED, __HIP_MEMORY_SCOPE_AGENT); }
__device__ __forceinline__ unsigned xb_xcc_id() { return (unsigned)__builtin_amdgcn_s_getreg((3 << 11) | 20) & 0xFu; }
#define XB_SPIN(cond, bar) do { unsigned _sp = 0; while (cond) { __builtin_amdgcn_s_sleep(1); \
    if ((++_sp & 255u) == 0u) { if (xb_ld(&(bar)[XB_TMO])) break; if (_sp > XB_SPIN_CAP) { atomicAdd(&(bar)[XB_TMO], 1u); break; } } } } while (0)
__device__ __forceinline__ void xcd_barrier_complete(unsigned* bar, unsigned x, unsigned& nloc, unsigned& nx) {
    const unsigned G = gridDim.x * gridDim.y * gridDim.z;
    unsigned sum, cnt, mine, sp = 0u;
    for (;;) {
        sum = 0u; cnt = 0u; mine = 0u;
#pragma unroll
        for (unsigned j = 0; j < 16; ++j) { const unsigned c = xb_ld(&bar[XB_XCNT(j)]); sum += c; cnt += (c > 0u) ? 1u : 0u; mine = (j == x) ? c : mine; }
        if (sum == G) break;
        __builtin_amdgcn_s_sleep(1);
        if ((++sp & 255u) == 0u) { if (xb_ld(&bar[XB_TMO])) break; if (sp > XB_SPIN_CAP) { atomicAdd(&bar[XB_TMO], 1u); break; } }
    }
    nloc = mine > 0u ? mine : 1u; nx = cnt > 0u ? cnt : 1u;
}
__device__ __forceinline__ void xcd_barrier(unsigned* bar, volatile LAS unsigned* st) {
    asm volatile("s_waitcnt vmcnt(0)" ::: "memory");
    __syncthreads();
    if (threadIdx.x == 0) {
        const unsigned x = xb_xcc_id();
        __builtin_amdgcn_s_waitcnt(0);
        unsigned nloc = st[0], nx = st[1];
        if (nloc == 0u) { xcd_barrier_complete(bar, x, nloc, nx); st[0] = nloc; st[1] = nx; }
        const unsigned old = xb_add(&bar[XB_XSUB(x)], 1u);
        const unsigned gen = old / nloc;
        if (old + 1u == (gen + 1u) * nloc) {
            __builtin_amdgcn_fence(__ATOMIC_RELEASE, "agent");
            asm volatile("s_waitcnt vmcnt(0)" ::: "memory");
            const unsigned og = xb_add(&bar[XB_TOP], 1u);
            const unsigned tg = og / nx;
            if (og + 1u == (tg + 1u) * nx) xb_add(&bar[XB_TOPGEN], 1u);
            else XB_SPIN(xb_ld(&bar[XB_TOPGEN]) == tg, bar);
            __builtin_amdgcn_fence(__ATOMIC_ACQUIRE, "agent");
            xb_add(&bar[XB_XGEN(x)], 1u);
            asm volatile("s_waitcnt vmcnt(0)" ::: "memory");
        } else {
            XB_SPIN(xb_ld(&bar[XB_XGEN(x)]) == gen, bar);
            __builtin_amdgcn_fence(__ATOMIC_ACQUIRE, "agent");
            asm volatile("s_waitcnt vmcnt(0)" ::: "memory");
        }
    }
    __syncthreads();
}

__device__ __forceinline__ int next_tile(unsigned* ctr, unsigned char* lds) {
    int* sh = (int*)(lds + LDS_BYTES - 16);
    __syncthreads();
    if (ltid() == 0) *sh = (int)atomicAdd(ctr, 1u);
    __syncthreads();
    return *sh;
}

struct Ids { int tid, lane, wave, gw, NGW; long gt, GT; };
__device__ __forceinline__ Ids get_ids() {
    Ids I; const int tid = ltid();
    I.tid = tid; I.lane = tid & 63; I.wave = tid >> 6; I.gw = blockIdx.x * 8 + I.wave; I.NGW = gridDim.x * 8; I.gt = (long)blockIdx.x * 512 + tid; I.GT = (long)gridDim.x * 512; return I;
}
#define GSYNC() xcd_barrier((unsigned*)(get_params()->ws + WS_BAR), (volatile LAS unsigned*)((LAS unsigned char*)lds + (LDS_BYTES - 32)))

__global__ void __launch_bounds__(512, 2) mega(Params p_unused) {
    extern __shared__ __attribute__((aligned(16))) unsigned char lds[];
    { unsigned* bar0 = (unsigned*)(get_params()->ws + WS_BAR);
      if (ltid() == 0) { volatile LAS unsigned* st = (volatile LAS unsigned*)((LAS unsigned char*)lds + (LDS_BYTES - 32)); st[0] = 0u; st[1] = 0u;
        (void)xb_add(&bar0[XB_XCNT(xb_xcc_id())], 1u); } }
    __syncthreads();
    { const Ids I = get_ids(); phase0(get_params(), lds, I.gw, I.NGW, I.gt, I.GT, I.lane, I.wave); }
    GSYNC();
    if (gridDim.x == 0x7fffffffu) cg::this_grid().sync();

    for (int step = 0; step < 12; ++step) {
        const int l = step / 3, sub = step - l * 3, e = l >> 1, odd = l & 1, f = l * 2 + (sub == 2 ? 1 : 0);
        if (sub != 1) {
            unsigned char* ws = get_params()->ws;
            pg8::Gemm g{(const bf16_t*)(ws + WS_XG), (const bf16_t*)(ws + WS_WGU + (size_t)f * SZ_WGU), MP, 5632, 1024};
            pg8::EpiSwiGLU E{(bf16_t*)(ws + WS_P), (const u64*)(ws + WS_SSQ) + (size_t)(3 * l + sub) * MP};
            pg8::StaticOrder S; S.init(MP, 5632, (int)gridDim.x, (int)blockIdx.x);
            pg8::gemm_phase((LAS unsigned char*)lds, g, S, E);
            GSYNC();
        } else {
            {
                unsigned char* ws = get_params()->ws;
                pg8::Gemm g{(const bf16_t*)(ws + WS_XG), (const bf16_t*)(odd ? ws + WS_WOIN + (size_t)e * SZ_WOIN : ws + WS_WEIN + (size_t)e * SZ_WEIN), MP, odd ? OINP : EINP, 1024};
                pg8::EpiRowScale E{(bf16_t*)(ws + WS_P), odd ? OINP : EINP, (const u64*)(ws + WS_SSQ) + (size_t)(3 * l + 1) * MP, (float*)(ws + WS_GATE), odd ? 20 : 11};
                pg8::StaticOrder S; S.init(odd ? MP : TP, odd ? OINP : EINP, (int)gridDim.x, (int)blockIdx.x);
                pg8::gemm_phase((LAS unsigned char*)lds, g, S, E);
                if (!odd) skinny_inproj(g.A, g.Bt, E.C, EINP, E.ssq, E.gate, 2816, 177, lds);
            }
            GSYNC();
            if (!odd) {
                gdn_prep_phase(get_params(), e, lds);
                { const Ids I = get_ids(); even_prep(get_params(), e, I.gw, I.NGW, I.gt, I.GT, I.lane); }
                GSYNC();
                for (;;) {
                    const int t = next_tile((unsigned*)(get_params()->ws + WS_CTL) + 64 * l, lds);
                    if (t >= 1184) break;
                    if (t < 32) gdn_chunk_scan_tile(get_params(), e, t, lds);
                    else if (t < 160) attn_dec_tile(get_params(), e, t - 32, lds);
                    else if (t < 672) gdn_dec_tile(get_params(), e, t - 160, lds);
                    else attn_tile(get_params(), e, t - 672, lds);
                }
                GSYNC();
                { const Ids I = get_ids(); even_post(get_params(), e, I.gw, I.NGW, I.lane); }
                GSYNC();
            } else {
                { const Ids I = get_ids(); odd_prep(get_params(), e, I.gt, I.GT); }
                GSYNC();
                for (;;) {
                    const int t = next_tile((unsigned*)(get_params()->ws + WS_CTL) + 64 * l, lds);
                    if (t >= 768) break;
                    if (t < 256) ssd_chunk_tile(get_params(), e, t, lds);
                    else ssd_dec_tile(get_params(), e, t - 256);
                }
                GSYNC();
                { const Ids I = get_ids(); odd_post(get_params(), e, I.gw, I.NGW, I.lane); }
                GSYNC();
            }
        }
        {
            PP p = get_params(); unsigned char* ws = p->ws;
            pg8::Gemm g;
            float scale;
            if (sub != 1) { g = pg8::Gemm{(const bf16_t*)(ws + WS_P), (const bf16_t*)(ws + WS_WD + (size_t)f * SZ_WD), MP, 1024, DFF}; scale = 0.5f; }
            else { g = pg8::Gemm{(const bf16_t*)(ws + WS_MIX), (const bf16_t*)(odd ? ws + WS_WOOUT + (size_t)e * SZ_WOOUT : ws + WS_WEOUT + (size_t)e * SZ_WEOUT), MP, 1024, odd ? 2048 : 1024}; scale = 1.0f; }
            const float* gnext = sub == 0 ? p->in[10] + l * D : (sub == 1 ? p->in[11] + l * D : (l < 3 ? p->in[9] + (l + 1) * D : p->in[12]));
            pg8::EpiResidual E{(float*)(ws + WS_X), (bf16_t*)(ws + WS_XG), gnext, (u64*)(ws + WS_SSQ) + (size_t)(3 * l + sub + 1) * MP, scale};
            pg8::StaticOrder S; S.init(TP, 1024, (int)gridDim.x, (int)blockIdx.x);
            pg8::gemm_phase((LAS unsigned char*)lds, g, S, E);
            skinny_residual(g.A, g.Bt, g.K, E.X, E.XG, E.gnext, E.ssqn, E.scale, lds);
            GSYNC();
        }
    }
    { PP p = get_params(); const Ids I = get_ids(); const u64* sf = (const u64*)(p->ws + WS_SSQ) + 12ull * MP; const float* g = p->in[12]; const float* X = (const float*)(p->ws + WS_X);
      for (int r = I.gw; r < T; r += I.NGW) {
        const float rs = rsqrtf((float)sf[r] * SSQ_INV + EPS);
#pragma unroll
        for (int j = 0; j < 4; ++j) { const int c = (I.lane + 64 * j) * 4; *(f32x4*)(p->out + (size_t)r * D + c) = *(const f32x4*)(X + (size_t)r * D + c) * *(const f32x4*)(g + c) * rs; }
      } }
}

extern "C" void kernel_launch(void* const* d_in, const int* in_sizes, int n_in, void* d_out, int out_size, void* d_ws, size_t ws_size, hipStream_t stream) {
    static int grid = 0;
    if (grid == 0) {
        if (n_in != 34 || (size_t)out_size != O_END || ws_size < WS_END) { fprintf(stderr, "kernel_launch: unexpected shapes: n_in %d out %d ws %zu (need %zu)\n", n_in, out_size, ws_size, (size_t)WS_END); grid = -1; return; }
        int dev = 0, cus = 0, per_cu = 0;
        (void)hipGetDevice(&dev);
        (void)hipDeviceGetAttribute(&cus, hipDeviceAttributeMultiprocessorCount, dev);
        (void)hipFuncSetAttribute((const void*)mega, hipFuncAttributeMaxDynamicSharedMemorySize, LDS_BYTES);
        (void)hipOccupancyMaxActiveBlocksPerMultiprocessor(&per_cu, (const void*)mega, 512, LDS_BYTES);
        if (per_cu < 1) per_cu = 1;
        grid = cus * per_cu;
    }
    if (grid < 0) return;
    (void)hipMemsetAsync((unsigned char*)d_ws + WS_BAR, 0, 16384, stream);
    Params p{};
    for (int i = 0; i < 34; ++i) p.in[i] = (const float*)d_in[i];
    p.out = (float*)d_out; p.ws = (unsigned char*)d_ws;
    void* args[] = {&p};
    hipError_t e = hipLaunchCooperativeKernel((const void*)mega, dim3(grid), dim3(512), args, LDS_BYTES, stream);
    if (e != hipSuccess) fprintf(stderr, "cooperative launch failed: %s (grid %d)\n", hipGetErrorString(e), grid);
}
```
